# Optimizing an MI355X kernel written in HIP

```python
import jax, jax.numpy as jnp
from jax import lax
import numpy as np

D_MODEL = 1024
BATCH = 8
SEQ = 4096
DEPTH = 4

D_MIX = D_MODEL
SB_HEAD_DIM = 64
SB_HEADS = (D_MIX // 2) // SB_HEAD_DIM
SB_WIDTH = SB_HEADS * SB_HEAD_DIM
SB_BLOCK = 128
GLA_HEADS = 4
GLA_DV = (D_MIX // 2) // GLA_HEADS
GLA_DK = GLA_DV // 2
GLA_K_WIDTH = GLA_HEADS * GLA_DK
GLA_V_WIDTH = GLA_HEADS * GLA_DV
GLA_RANK = 16
GLA_GATE_NORM = 16.0
GLA_CHUNK = 64
D_IN_PROJ = 3 * SB_WIDTH + 2 * GLA_K_WIDTH + 2 * GLA_V_WIDTH + GLA_RANK
N_GROUPS = 4
EXPERTS_PER_GROUP = 8
TOP_K_IN_GROUP = 2
D_EXPERT = 256
N_MOD = 6
EPS = 1e-6

kernel_name = "hybrid_sb_gla_hmoe_adaln"


def rms_norm(x, gain):
    xf = x.astype(jnp.float32)
    y = xf * lax.rsqrt(jnp.mean(xf * xf, axis=-1, keepdims=True) + EPS)
    return (y * gain.astype(jnp.float32)).astype(x.dtype)


def split_heads(t, n_heads):
    b, s, w = t.shape
    return t.reshape(b, s, n_heads, w // n_heads).transpose(0, 2, 1, 3)


def merge_heads(t):
    b, h, s, d = t.shape
    return t.transpose(0, 2, 1, 3).reshape(b, s, h * d)


def stick_breaking_attention(q, k, v):
    B, H, S, d = q.shape
    nb = S // SB_BLOCK
    scale = d ** -0.5
    q_blocks = jnp.moveaxis(q.reshape(B, H, nb, SB_BLOCK, d), 2, 0)
    key_pos = jnp.arange(S)

    def one_block(args):
        q_blk, blk = args
        z = jnp.einsum('bhqd,bhkd->bhqk', q_blk, k).astype(jnp.float32) * scale
        query_pos = blk * SB_BLOCK + jnp.arange(SB_BLOCK)
        before = key_pos[None, :] < query_pos[:, None]
        log_fail = jnp.where(before, -jax.nn.softplus(z), 0.0)
        suffix = lax.cumsum(log_fail, axis=3, reverse=True) - log_fail
        w = jnp.where(before, jnp.exp(jax.nn.log_sigmoid(z) + suffix), 0.0)
        return jnp.einsum('bhqk,bhkd->bhqd', w.astype(v.dtype), v)

    out = lax.map(one_block, (q_blocks, jnp.arange(nb)))
    return jnp.moveaxis(out, 0, 2).reshape(B, H, S, d)


def gla_chunked(q, k, v, log_g):
    B, H, S, dk = q.shape
    dv = v.shape[-1]
    C = GLA_CHUNK
    nc = S // C
    f32 = jnp.float32
    qc = q.astype(f32).reshape(B, H, nc, C, dk) * (dk ** -0.5)
    kc = k.astype(f32).reshape(B, H, nc, C, dk)
    vc = v.astype(f32).reshape(B, H, nc, C, dv)
    b = jnp.cumsum(log_g.astype(f32).reshape(B, H, nc, C, dk), axis=3)
    b_last = b[:, :, :, -1:, :]
    q_dec = qc * jnp.exp(b)
    k_inv = kc * jnp.exp(-b)
    causal = jnp.tril(jnp.ones((C, C), dtype=bool))
    scores = jnp.where(causal, jnp.einsum('bhnqd,bhnkd->bhnqk', q_dec, k_inv), 0.0)
    intra = jnp.einsum('bhnqk,bhnkv->bhnqv', scores, vc)
    chunk_kv = jnp.einsum('bhnkd,bhnkv->bhndv', kc * jnp.exp(b_last - b), vc)
    chunk_decay = jnp.exp(b_last[:, :, :, 0, :])

    def step(state, inp):
        dec, kv_c = inp
        return dec[..., None] * state + kv_c, state

    _, prev = lax.scan(step, jnp.zeros((B, H, dk, dv), f32),
                       (jnp.moveaxis(chunk_decay, 2, 0), jnp.moveaxis(chunk_kv, 2, 0)))
    prev = jnp.moveaxis(prev, 0, 2)
    inter = jnp.einsum('bhnqd,bhndv->bhnqv', q_dec, prev)
    return (intra + inter).reshape(B, H, S, dv).astype(v.dtype)


def hybrid_mixer(h, w_in, w_gk2, b_gk, q_gain, k_gain, gla_gain, w_out):
    proj = h @ w_in
    widths = (SB_WIDTH, SB_WIDTH, SB_WIDTH, GLA_K_WIDTH, GLA_K_WIDTH,
              GLA_V_WIDTH, GLA_V_WIDTH, GLA_RANK)
    cuts = np.cumsum(widths)[:-1].tolist()
    sb_q, sb_k, sb_v, g_q, g_k, g_v, g_r, g_lr = jnp.split(proj, cuts, axis=-1)
    qa = rms_norm(split_heads(sb_q, SB_HEADS), q_gain)
    ka = rms_norm(split_heads(sb_k, SB_HEADS), k_gain)
    out_a = merge_heads(stick_breaking_attention(qa, ka, split_heads(sb_v, SB_HEADS)))
    log_g = jax.nn.log_sigmoid((g_lr @ w_gk2 + b_gk).astype(jnp.float32)) / GLA_GATE_NORM
    o_b = gla_chunked(split_heads(g_q, GLA_HEADS), split_heads(g_k, GLA_HEADS),
                      split_heads(g_v, GLA_HEADS), split_heads(log_g, GLA_HEADS))
    out_b = merge_heads(rms_norm(o_b, gla_gain)) * jax.nn.silu(g_r)
    return jnp.concatenate([out_a, out_b], axis=-1) @ w_out


def hierarchical_moe(h, w_router_grp, b_router_grp, w_router_exp, b_router_exp,
                     w_gate, w_up, w_down):
    B, S, D = h.shape
    hf = h.reshape(B * S, D)
    f32 = jnp.float32
    grp_prob = jax.nn.softmax((hf @ w_router_grp + b_router_grp).astype(f32), axis=-1)
    grp_w, grp_idx = lax.top_k(grp_prob, 1)
    exp_logits = (hf @ w_router_exp + b_router_exp).astype(f32).reshape(-1, N_GROUPS, EXPERTS_PER_GROUP)
    sel_logits = jnp.take_along_axis(exp_logits, grp_idx[:, :, None], axis=1)[:, 0]
    top_logit, top_idx = lax.top_k(sel_logits, TOP_K_IN_GROUP)
    top_w = jax.nn.softmax(top_logit, axis=-1) * grp_w
    exp_w = jnp.sum(jax.nn.one_hot(top_idx, EXPERTS_PER_GROUP, dtype=f32) * top_w[..., None], axis=1)
    comb = (jax.nn.one_hot(grp_idx[:, 0], N_GROUPS, dtype=f32)[:, :, None]
            * exp_w[:, None, :]).astype(h.dtype)
    y = jnp.zeros_like(hf)
    for g in range(N_GROUPS):
        a = jnp.einsum('nd,edf->nef', hf, w_gate[g])
        u = jnp.einsum('nd,edf->nef', hf, w_up[g])
        y = y + jnp.einsum('nef,efd->nd', jax.nn.silu(a) * u * comb[:, g, :, None], w_down[g])
    return y.reshape(B, S, D)


def setup_inputs(seed: int = 0) -> dict:
    key = jax.random.key(seed)
    ks = jax.random.split(key, 20)
    f32 = jnp.float32
    nrm = lambda k, shape, s: jax.random.normal(k, shape, f32) * s
    L, D = DEPTH, D_MODEL
    return {
        "x": nrm(ks[0], (BATCH, SEQ, D), 1.0),
        "c": nrm(ks[1], (BATCH, D), 1.0),
        "w_ada": nrm(ks[2], (L, D, N_MOD * D), 0.5 * D ** -0.5),
        "b_ada": nrm(ks[3], (L, N_MOD * D), 0.02),
        "norm_mix": 1.0 + nrm(ks[4], (L, D), 0.02),
        "norm_ffn": 1.0 + nrm(ks[5], (L, D), 0.02),
        "w_in": nrm(ks[6], (L, D, D_IN_PROJ), D ** -0.5),
        "w_gk2": nrm(ks[7], (L, GLA_RANK, GLA_K_WIDTH), GLA_RANK ** -0.5),
        "b_gk": 2.0 + nrm(ks[8], (L, GLA_K_WIDTH), 0.1),
        "q_gain": 1.0 + nrm(ks[9], (L, SB_HEAD_DIM), 0.02),
        "k_gain": 1.0 + nrm(ks[10], (L, SB_HEAD_DIM), 0.02),
        "gla_gain": 1.0 + nrm(ks[11], (L, GLA_DV), 0.02),
        "w_out": nrm(ks[12], (L, D_MIX, D), D_MIX ** -0.5),
        "w_router_grp": nrm(ks[13], (L, D, N_GROUPS), D ** -0.5),
        "b_router_grp": nrm(ks[14], (L, N_GROUPS), 0.01),
        "w_router_exp": nrm(ks[15], (L, D, N_GROUPS * EXPERTS_PER_GROUP), D ** -0.5),
        "b_router_exp": nrm(ks[16], (L, N_GROUPS * EXPERTS_PER_GROUP), 0.01),
        "w_gate": nrm(ks[17], (L, N_GROUPS, EXPERTS_PER_GROUP, D, D_EXPERT), D ** -0.5),
        "w_up": nrm(ks[18], (L, N_GROUPS, EXPERTS_PER_GROUP, D, D_EXPERT), D ** -0.5),
        "w_down": nrm(ks[19], (L, N_GROUPS, EXPERTS_PER_GROUP, D_EXPERT, D), D_EXPERT ** -0.5),
    }


def reference(x, c, w_ada, b_ada, norm_mix, norm_ffn, w_in, w_gk2, b_gk, q_gain, k_gain,
              gla_gain, w_out, w_router_grp, b_router_grp, w_router_exp, b_router_exp,
              w_gate, w_up, w_down):
    c_act = jax.nn.silu(c)
    for l in range(DEPTH):
        mod = (c_act @ w_ada[l] + b_ada[l])[:, None, :]
        shift_m, scale_m, gate_m, shift_f, scale_f, gate_f = jnp.split(mod, N_MOD, axis=-1)
        h = rms_norm(x, norm_mix[l]) * (1.0 + scale_m) + shift_m
        x = x + gate_m * hybrid_mixer(h, w_in[l], w_gk2[l], b_gk[l], q_gain[l], k_gain[l],
                                      gla_gain[l], w_out[l])
        h = rms_norm(x, norm_ffn[l]) * (1.0 + scale_f) + shift_f
        x = x + gate_f * hierarchical_moe(h, w_router_grp[l], b_router_grp[l], w_router_exp[l],
                                          b_router_exp[l], w_gate[l], w_up[l], w_down[l])
    return x
```

```cpp
#include <hip/hip_runtime.h>
#include <cstdio>
#include <cstdint>

#define GAS __attribute__((address_space(1)))
#define LAS __attribute__((address_space(3)))
typedef unsigned short bf16;
typedef unsigned short bf16_t;
typedef short bf16x8 __attribute__((ext_vector_type(8)));
typedef float f32x4 __attribute__((ext_vector_type(4)));
typedef float f32x2 __attribute__((ext_vector_type(2)));
typedef unsigned u32x4 __attribute__((ext_vector_type(4)));
typedef unsigned u32x2 __attribute__((ext_vector_type(2)));
typedef GAS unsigned gu32;

constexpr int DM = 1024, NB = 8, SEQ = 4096, NL = 4, NTOK = NB * SEQ;
constexpr int SBW = 512, SBH = 8, SBD = 64;
constexpr int GH = 4, GDK = 64, GDV = 128, GKW = 256, GVW = 512, GRANK = 16;
constexpr int DIN = 3088, PROJW = 3072;
constexpr int NGRP = 4, EPG = 8, NEXP = 32, DEXP = 256, NMOD = 6;
constexpr float EPS = 1e-6f;
constexpr float LOG2E = 1.4426950408889634f;
constexpr float QSCALE = 0.125f * LOG2E;
constexpr int PC_Q = 0, PC_K = 512, PC_V = 1024, PC_GQ = 1536, PC_GK = 1792, PC_GV = 2048, PC_GR = 2560;
constexpr int MAXSLOT = 73728;

constexpr size_t MiB = 1u << 20;
constexpr size_t WS_CTL = 0, CTL_ZERO_BYTES = 1 * MiB;
constexpr size_t WS_MOD = 1 * MiB;
constexpr size_t WS_WIN = 4 * MiB;
constexpr size_t WS_WOUT = 28 * MiB;
constexpr size_t WS_W1 = 36 * MiB;
constexpr size_t WS_W2 = 164 * MiB;
constexpr size_t WS_H = 228 * MiB;
constexpr size_t WS_MIX = 292 * MiB;
constexpr size_t WS_PROJ = 356 * MiB;
constexpr size_t WS_ACT = 356 * MiB;
constexpr size_t WS_Y = 400 * MiB;
constexpr size_t WS_GLR = 548 * MiB;
constexpr size_t WS_LG = 550 * MiB;
constexpr size_t WS_OB = 582 * MiB;
constexpr size_t WS_TOKE = 646 * MiB;
constexpr size_t WS_TOKP = WS_TOKE + 256 * 1024;
constexpr size_t WS_TOKW = WS_TOKP + 256 * 1024;
constexpr size_t WS_TOKOF = 647 * MiB;
constexpr size_t WS_SLOTW = 651 * MiB;
constexpr size_t WS_END = 655 * MiB;
static_assert(WS_ACT + (size_t)MAXSLOT * DEXP * 2 <= WS_Y && WS_Y + (size_t)MAXSLOT * DM * 2 <= WS_PROJ + (size_t)NTOK * PROJW * 2 && WS_PROJ + (size_t)NTOK * PROJW * 2 <= WS_GLR, "ws map");
constexpr int CW_TMO = 0;
constexpr int CW_BAR = 4096;
constexpr int CW_CNT = 16384;

constexpr int RING_BYTES = 131072;
constexpr int LDSCTL_OFF = RING_BYTES, MISC_OFF = LDSCTL_OFF + 320;
constexpr int LDS_BYTES = 147456;

#define RLX_AGENT __ATOMIC_RELAXED, __HIP_MEMORY_SCOPE_AGENT
#define LDS_WAIT() asm volatile("s_waitcnt lgkmcnt(0)" ::: "memory")
#define VM_WAIT() asm volatile("s_waitcnt vmcnt(0)" ::: "memory")
__device__ __forceinline__ unsigned f2bf(float f) { unsigned u = __builtin_bit_cast(unsigned, f); return (u + 0x7fffu + ((u >> 16) & 1u)) >> 16; }
__device__ __forceinline__ unsigned pk2(float lo, float hi) { return f2bf(lo) | (f2bf(hi) << 16); }
__device__ __forceinline__ float bf2f(unsigned short b) { return __builtin_bit_cast(float, (unsigned)b << 16); }
__device__ __forceinline__ float bflo(unsigned w) { return __builtin_bit_cast(float, w << 16); }
__device__ __forceinline__ float bfhi(unsigned w) { return __builtin_bit_cast(float, w & 0xffff0000u); }
__device__ __forceinline__ float siluf(float v) { return v / (1.f + __expf(-v)); }
__device__ __forceinline__ float wave_sum(float v) {
#pragma unroll
    for (int o = 1; o < 64; o <<= 1) v += __shfl_xor(v, o);
    return v;
}

namespace pg8 {
constexpr int BM = 256, BK = 64, HALF = 128, HTB = HALF * BK * 2, NXCD = 8, WGM = 8;
__host__ __device__ __forceinline__ int lds_byte(int r, int c) { const int st = (r >> 4) * 2 + (c >> 5), rr = r & 15, cc = c & 31, ob = rr * 64 + cc * 2; return st * 1024 + (ob ^ (((ob >> 9) & 1) << 5)); }
__host__ __device__ __forceinline__ void stage_rc(int b, int& R, int& C) { const int st = b / 1024, sb = b % 1024, swz = sb ^ (((sb >> 9) & 1) << 5); R = (st >> 1) * 16 + swz / 64; C = (st & 1) * 32 + (swz % 64) / 2; }
__host__ __device__ __forceinline__ int perm32(int rho) { const int n = rho >> 4, i = rho & 15; return 8 * (i >> 2) + 4 * n + (i & 3); }

struct Unit { int pm, pn, pb, aux; };
struct Gemm { const bf16_t* A; const bf16_t* Bt; int K; const int* rowmap; };

struct StaticOrder {
    int nM, nN, nwg, G, c;
    __device__ void init(int M, int N, int G_, int c_) { nM = M / BM; nN = N / BM; nwg = nM * nN; G = G_; c = c_; }
    __device__ bool next(int i, Unit& u) const {
        const long L = (long)i * G + c; if (L >= nwg) return false;
        int wgid = (int)L; { const int q = nwg / NXCD, r = nwg % NXCD, xcd = wgid % NXCD, off = wgid / NXCD; wgid = (xcd < r ? xcd * (q + 1) : r * (q + 1) + (xcd - r) * q) + off; }
        const int nig = WGM * nN, gid = wgid / nig, fm = gid * WGM, gsz = (nM - fm) < WGM ? (nM - fm) : WGM;
        u.pm = fm + ((wgid % nig) % gsz); u.pn = (wgid % nig) / gsz; u.pb = u.pn; u.aux = 0; return true;
    }
};
struct GroupedOrder {
    const LAS int* tb; int nN, G, c;
    __device__ bool next(int i, Unit& u) const {
        const int L = i * G + c; const int mt = L / nN, ntile = L - mt * nN;
        if (mt >= __builtin_amdgcn_readfirstlane(tb[NEXP])) return false;
        int e = 0, te = 0;
        for (int j = 1; j < NEXP; ++j) { const int tj = __builtin_amdgcn_readfirstlane(tb[j]); if (mt >= tj) { e = j; te = tj; } }
        u.pm = mt; u.pn = ntile; u.pb = e * nN + ntile; u.aux = e * NTOK + (mt - te) * 256;
        return true;
    }
};

__device__ __forceinline__ unsigned cvt_pk_bf16(float lo, float hi) { unsigned r; asm volatile("v_cvt_pk_bf16_f32 %0, %1, %2" : "=v"(r) : "v"(lo), "v"(hi)); return r; }

template <class Epi, class Sched, bool GATHER, bool ALIGN_EPI, bool SP2>
__device__ __forceinline__ void gemm_phase(LAS unsigned char* lds, const Gemm g, const Sched& S, const Epi& E) {
    const int tid = threadIdx.x, wid = __builtin_amdgcn_readfirstlane(tid >> 6), lane = tid & 63, wr = wid >> 2, wc = wid & 3, fr = lane & 15, fq = lane >> 4;
    int K = g.K; asm volatile("" : "+s"(K)); const int nt = K / BK;
    unsigned voffB[2];
#pragma unroll
    for (int i = 0; i < 2; ++i) { int R, C; stage_rc(tid * 16 + i * 8192, R, C); const int Rb = Epi::PERM ? ((R & ~31) + perm32(R & 31)) : R;
        voffB[i] = (unsigned)(Rb * K + C) * 2u; }
    const size_t kstep = (size_t)(BK * 2);
    const size_t hstep = (size_t)HALF * K * 2;
    const size_t tstep = 2 * hstep;
    const unsigned ldsw = (unsigned)wid * 1024u;
    const int aoff = lds_byte(wr * 64 + fr, fq * 8), boff = lds_byte(wc * 32 + fr, fq * 8);
#define PG8_SA(b, h) (((b) * 2 + (h)) * HTB)
#define PG8_SB(b, h) ((4 + (b) * 2 + (h)) * HTB)
#define PG8_STAGE(bufoff, gbase, voff) do { _Pragma("unroll") for (int _i = 0; _i < 2; ++_i) \
        __builtin_amdgcn_global_load_lds((const unsigned*)((const char*)(gbase) + (voff)[_i]), (LAS unsigned*)(lds + (bufoff) + ldsw + _i * 8192), 16, 0, 0); } while (0)
#define PG8_LDA(dst, b, h) do { _Pragma("unroll") for (int m = 0; m < 4; ++m) _Pragma("unroll") for (int k = 0; k < 2; ++k) dst[m][k] = *(const LAS bf16x8*)(lds + PG8_SA(b, h) + aoff + m * 2048 + k * 1024); } while (0)
#define PG8_LDB(dst, b, h) do { _Pragma("unroll") for (int n = 0; n < 2; ++n) _Pragma("unroll") for (int k = 0; k < 2; ++k) dst[n][k] = *(const LAS bf16x8*)(lds + PG8_SB(b, h) + boff + n * 2048 + k * 1024); } while (0)
#define PG8_MMA(ai, bj, At, Bt) do { __builtin_amdgcn_s_setprio(1); _Pragma("unroll") for (int m = 0; m < 4; ++m) _Pragma("unroll") for (int n = 0; n < 2; ++n) _Pragma("unroll") for (int k = 0; k < 2; ++k) \
        acc[ai][bj][m][n] = __builtin_amdgcn_mfma_f32_16x16x32_bf16(Bt[n][k], At[m][k], acc[ai][bj][m][n], 0, 0, 0); __builtin_amdgcn_s_setprio(0); } while (0)
#define PG8_WAIT_V(n) asm volatile("s_waitcnt vmcnt(" #n ")" ::: "memory")
#define PG8_WAIT_L(n) asm volatile("s_waitcnt lgkmcnt(" #n ")" ::: "memory")
#define PG8_BAR __builtin_amdgcn_s_barrier()
#define PG8_SCHED __builtin_amdgcn_sched_barrier(0)
#define PG8_SETA(V0, V1, u) do { _Pragma("unroll") for (int _i = 0; _i < 2; ++_i) { int r0, r1, Rp_, Cp_; stage_rc(tid * 16 + _i * 8192, Rp_, Cp_); \
        if (GATHER) { r0 = g.rowmap[(u).aux + Rp_]; r1 = g.rowmap[(u).aux + HALF + Rp_]; } else { r0 = (u).pm * BM + Rp_; r1 = r0 + HALF; } \
        V0[_i] = (unsigned)(r0 * K + Cp_) * 2u; V1[_i] = (unsigned)(r1 * K + Cp_) * 2u; } } while (0)
    Unit cur, nxt; int ui = 0;
    if (!S.next(0, cur)) return;
    f32x4 acc[2][2][4][2];
#pragma unroll
    for (int a = 0; a < 2; ++a)
#pragma unroll
        for (int b = 0; b < 2; ++b)
#pragma unroll
            for (int m = 0; m < 4; ++m)
#pragma unroll
                for (int n = 0; n < 2; ++n) acc[a][b][m][n] = (f32x4){0.f, 0.f, 0.f, 0.f};
    bf16x8 At[4][2], B0[2][2], B1[2][2];
    unsigned cA0[2], cA1[2], nA0[2], nA1[2];
    PG8_SETA(cA0, cA1, cur);
    const char* const gA = (const char*)g.A;
    const char* cB = (const char*)g.Bt + (size_t)cur.pb * tstep;
    if constexpr (SP2) {
        PG8_STAGE(PG8_SB(0, 0), cB, voffB); PG8_STAGE(PG8_SB(0, 1), cB + hstep, voffB); PG8_STAGE(PG8_SA(0, 0), gA, cA0); PG8_STAGE(PG8_SA(0, 1), gA, cA1);
        if (wr == 1) PG8_BAR;
        PG8_WAIT_V(2); PG8_BAR;
        PG8_STAGE(PG8_SB(1, 0), cB + kstep, voffB); PG8_STAGE(PG8_SA(1, 0), gA + kstep, cA0); PG8_STAGE(PG8_SB(1, 1), cB + hstep + kstep, voffB);
        PG8_WAIT_V(6); PG8_BAR;
    } else {
        PG8_STAGE(PG8_SB(0, 0), cB, voffB); PG8_STAGE(PG8_SA(0, 0), gA, cA0); PG8_STAGE(PG8_SB(0, 1), cB + hstep, voffB); PG8_STAGE(PG8_SA(0, 1), gA, cA1);
        if (wr == 1) PG8_BAR;
        PG8_WAIT_V(4); PG8_BAR;
        PG8_STAGE(PG8_SB(1, 0), cB + kstep, voffB); PG8_STAGE(PG8_SA(1, 0), gA + kstep, cA0); PG8_STAGE(PG8_SB(1, 1), cB + hstep + kstep, voffB);
        PG8_WAIT_V(6); PG8_BAR;
    }
    for (;;) {
        const bool has_next = S.next(ui + 1, nxt);
        if (has_next) { PG8_SETA(nA0, nA1, nxt); } else {
#pragma unroll
            for (int _i = 0; _i < 2; ++_i) { nA0[_i] = cA0[_i]; nA1[_i] = cA1[_i]; } }
        const char* nB = has_next ? (const char*)g.Bt + (size_t)nxt.pb * tstep : cB;
#pragma unroll 1
        for (int t = 0; t < nt; t += 2) {
            const bool last = (t == nt - 2);
            const char* a1 = gA + (size_t)(t + 1) * kstep;
            const char* a2 = last ? gA : gA + (size_t)(t + 2) * kstep; const char* b2 = last ? nB : cB + (size_t)(t + 2) * kstep;
            const char* a3 = a2 + kstep; const char* b3 = b2 + kstep;
            unsigned xA0[2], xA1[2];
#pragma unroll
            for (int _i = 0; _i < 2; ++_i) { xA0[_i] = last ? nA0[_i] : cA0[_i]; xA1[_i] = last ? nA1[_i] : cA1[_i]; }
            if constexpr (SP2) {
            PG8_LDB(B0, 0, 0); PG8_LDB(B1, 0, 1); PG8_SCHED; PG8_LDA(At, 0, 0); PG8_STAGE(PG8_SA(1, 1), a1, cA1);
            PG8_WAIT_V(8); PG8_WAIT_L(0); PG8_BAR; PG8_MMA(0, 0, At, B0); PG8_MMA(0, 1, At, B1); PG8_BAR; PG8_SCHED;
            PG8_LDA(At, 0, 1); PG8_STAGE(PG8_SB(0, 0), b2, voffB); PG8_STAGE(PG8_SB(0, 1), b2 + hstep, voffB); PG8_STAGE(PG8_SA(0, 0), a2, xA0);
            PG8_WAIT_V(8); PG8_WAIT_L(0); PG8_BAR; PG8_MMA(1, 0, At, B0); PG8_MMA(1, 1, At, B1); PG8_BAR; PG8_SCHED;
            PG8_LDB(B0, 1, 0); PG8_LDB(B1, 1, 1); PG8_SCHED; PG8_LDA(At, 1, 0); PG8_STAGE(PG8_SA(0, 1), a2, xA1);
            PG8_WAIT_V(8); PG8_WAIT_L(0); PG8_BAR; PG8_MMA(0, 0, At, B0); PG8_MMA(0, 1, At, B1); PG8_BAR; PG8_SCHED;
            PG8_LDA(At, 1, 1); PG8_STAGE(PG8_SB(1, 0), b3, voffB); PG8_STAGE(PG8_SB(1, 1), b3 + hstep, voffB); PG8_STAGE(PG8_SA(1, 0), a3, xA0);
            PG8_WAIT_V(8); PG8_WAIT_L(0); PG8_BAR; PG8_MMA(1, 0, At, B0); PG8_MMA(1, 1, At, B1); PG8_BAR; PG8_SCHED;
            } else {
            PG8_LDB(B0, 0, 0); PG8_SCHED; PG8_LDA(At, 0, 0); PG8_STAGE(PG8_SA(1, 1), a1, cA1);
            PG8_WAIT_L(8); PG8_BAR; PG8_WAIT_L(0); PG8_MMA(0, 0, At, B0); PG8_BAR; PG8_SCHED;
            PG8_LDB(B1, 0, 1); PG8_STAGE(PG8_SB(0, 0), b2, voffB);
            PG8_BAR; PG8_WAIT_L(0); PG8_MMA(0, 1, At, B1); PG8_BAR;
            PG8_LDA(At, 0, 1); PG8_STAGE(PG8_SA(0, 0), a2, xA0);
            PG8_BAR; PG8_WAIT_L(0); PG8_MMA(1, 0, At, B0); PG8_BAR; PG8_SCHED;
            PG8_STAGE(PG8_SB(0, 1), b2 + hstep, voffB);
            PG8_WAIT_V(6); PG8_BAR; PG8_MMA(1, 1, At, B1); PG8_BAR;
            PG8_LDB(B0, 1, 0); PG8_SCHED; PG8_LDA(At, 1, 0); PG8_STAGE(PG8_SA(0, 1), a2, xA1);
            PG8_WAIT_L(8); PG8_BAR; PG8_WAIT_L(0); PG8_MMA(0, 0, At, B0); PG8_BAR; PG8_SCHED;
            PG8_LDB(B1, 1, 1); PG8_STAGE(PG8_SB(1, 0), b3, voffB);
            PG8_BAR; PG8_WAIT_L(0); PG8_MMA(0, 1, At, B1); PG8_BAR;
            PG8_LDA(At, 1, 1); PG8_STAGE(PG8_SA(1, 0), a3, xA0);
            PG8_BAR; PG8_WAIT_L(0); PG8_MMA(1, 0, At, B0); PG8_BAR; PG8_SCHED;
            PG8_STAGE(PG8_SB(1, 1), b3 + hstep, voffB);
            PG8_WAIT_V(6); PG8_BAR; PG8_MMA(1, 1, At, B1); PG8_BAR;
            }
        }
        if constexpr (ALIGN_EPI) { if (wr == 0) PG8_BAR; }
        E(acc, cur, wr, wc, fr, fq);
        if (!has_next) break;
#pragma unroll
        for (int a = 0; a < 2; ++a)
#pragma unroll
            for (int b = 0; b < 2; ++b)
#pragma unroll
                for (int m = 0; m < 4; ++m)
#pragma unroll
                    for (int n = 0; n < 2; ++n) acc[a][b][m][n] = (f32x4){0.f, 0.f, 0.f, 0.f};
        cur = nxt; cB = nB; ++ui;
#pragma unroll
        for (int _i = 0; _i < 2; ++_i) { cA0[_i] = nA0[_i]; cA1[_i] = nA1[_i]; }
        if constexpr (ALIGN_EPI) { if (wr == 1) PG8_BAR; }
    }
    PG8_WAIT_V(0);
    if constexpr (!ALIGN_EPI) { if (wr == 0) PG8_BAR; }
    PG8_BAR;
#undef PG8_SA
#undef PG8_SB
#undef PG8_STAGE
#undef PG8_LDA
#undef PG8_LDB
#undef PG8_MMA
#undef PG8_WAIT_V
#undef PG8_WAIT_L
#undef PG8_BAR
#undef PG8_SCHED
#undef PG8_SETA
}

struct EpiProj {
    static constexpr bool PERM = true;
    bf16_t* P; const float* qgain; const float* kgain;
    __device__ __forceinline__ void operator()(const f32x4 (&acc)[2][2][4][2], const Unit& u, int wr, int wc, int fr, int fq) const {
        asm volatile("" : "+v"(fr), "+v"(fq));
        const int row0 = u.pm * BM + wr * 64 + fr; const int pn = u.pn;
        if (pn < 4) {
            const float* gain = (pn < 2) ? qgain : kgain; const float sc = (pn < 2) ? QSCALE : 1.f;
            f32x4 gv[2][2];
#pragma unroll
            for (int bj = 0; bj < 2; ++bj)
#pragma unroll
                for (int n = 0; n < 2; ++n) gv[bj][n] = *(const f32x4*)(gain + 32 * bj + 8 * fq + 4 * n) * sc;
            const int col0 = 256 * pn + 64 * wc + 8 * fq;
#pragma unroll
            for (int ai = 0; ai < 2; ++ai)
#pragma unroll
                for (int m = 0; m < 4; ++m) {
                    float ss = 0.f;
#pragma unroll
                    for (int bj = 0; bj < 2; ++bj)
#pragma unroll
                        for (int n = 0; n < 2; ++n) { const f32x4 x = acc[ai][bj][m][n]; ss += (x[0] * x[0] + x[1] * x[1]) + (x[2] * x[2] + x[3] * x[3]); }
                    ss += __shfl_xor(ss, 16); ss += __shfl_xor(ss, 32);
                    const float rstd = __builtin_amdgcn_rsqf(ss * (1.f / 64.f) + EPS);
                    bf16_t* rowp = P + (size_t)(row0 + ai * HALF + m * 16) * PROJW + col0;
#pragma unroll
                    for (int bj = 0; bj < 2; ++bj) { const f32x4 v0 = acc[ai][bj][m][0] * rstd * gv[bj][0], v1 = acc[ai][bj][m][1] * rstd * gv[bj][1];
                        u32x4 w; w.x = cvt_pk_bf16(v0[0], v0[1]); w.y = cvt_pk_bf16(v0[2], v0[3]); w.z = cvt_pk_bf16(v1[0], v1[1]); w.w = cvt_pk_bf16(v1[2], v1[3]);
                        *(u32x4*)(rowp + bj * 32) = w; }
                }
        } else {
            const float sc = (pn == 6) ? 0.125f : 1.f; const bool act = (pn >= 10);
            const int col0 = 256 * pn + 32 * wc + 8 * fq;
#pragma unroll
            for (int ai = 0; ai < 2; ++ai)
#pragma unroll
                for (int m = 0; m < 4; ++m) { bf16_t* rowp = P + (size_t)(row0 + ai * HALF + m * 16) * PROJW + col0;
#pragma unroll
                    for (int bj = 0; bj < 2; ++bj) { f32x4 v0 = acc[ai][bj][m][0] * sc, v1 = acc[ai][bj][m][1] * sc;
                        if (act) {
#pragma unroll
                            for (int j = 0; j < 4; ++j) { v0[j] = siluf(v0[j]); v1[j] = siluf(v1[j]); } }
                        u32x4 w; w.x = cvt_pk_bf16(v0[0], v0[1]); w.y = cvt_pk_bf16(v0[2], v0[3]); w.z = cvt_pk_bf16(v1[0], v1[1]); w.w = cvt_pk_bf16(v1[2], v1[3]);
                        *(u32x4*)(rowp + bj * HALF) = w; } }
        }
    }
};
struct EpiResid {
    static constexpr bool PERM = true;
    const float* xin; float* X; const float* gate;
    __device__ __forceinline__ void operator()(const f32x4 (&acc)[2][2][4][2], const Unit& u, int wr, int wc, int fr, int fq) const {
        asm volatile("" : "+v"(fr), "+v"(fq));
        const int row0 = u.pm * BM + wr * 64 + fr; const int b = (u.pm * BM) / SEQ;
        const int col0 = u.pn * BM + wc * 32 + 8 * fq; const float* gp = gate + (size_t)b * (NMOD * DM);
#pragma unroll
        for (int ai = 0; ai < 2; ++ai)
#pragma unroll
            for (int m = 0; m < 4; ++m) { const size_t ro = (size_t)(row0 + ai * HALF + m * 16) * DM + col0;
#pragma unroll
                for (int bj = 0; bj < 2; ++bj)
#pragma unroll
                    for (int n = 0; n < 2; ++n) { const f32x4 xi = *(const f32x4*)(xin + ro + bj * HALF + 4 * n); const f32x4 gv = *(const f32x4*)(gp + col0 + bj * HALF + 4 * n);
                        *(f32x4*)(X + ro + bj * HALF + 4 * n) = xi + gv * acc[ai][bj][m][n]; }
                asm volatile("" ::: "memory"); }
    }
};
struct EpiMoeAct {
    static constexpr bool PERM = true;
    bf16_t* ACT; const float* slotw;
    __device__ __forceinline__ void operator()(const f32x4 (&acc)[2][2][4][2], const Unit& u, int wr, int wc, int fr, int fq) const {
        asm volatile("" : "+v"(fr), "+v"(fq));
        const int rl = wr * 64 + fr; const int col0 = 128 * u.pn + 32 * wc + 8 * fq;
#pragma unroll
        for (int ai = 0; ai < 2; ++ai)
#pragma unroll
            for (int m = 0; m < 4; ++m) { const int r = rl + ai * HALF + m * 16; const float w = slotw[u.aux + r];
                f32x4 g0 = acc[ai][0][m][0], g1 = acc[ai][0][m][1]; const f32x4 u0 = acc[ai][1][m][0], u1 = acc[ai][1][m][1];
#pragma unroll
                for (int j = 0; j < 4; ++j) { g0[j] = siluf(g0[j]) * u0[j] * w; g1[j] = siluf(g1[j]) * u1[j] * w; }
                u32x4 o; o.x = cvt_pk_bf16(g0[0], g0[1]); o.y = cvt_pk_bf16(g0[2], g0[3]); o.z = cvt_pk_bf16(g1[0], g1[1]); o.w = cvt_pk_bf16(g1[2], g1[3]);
                *(u32x4*)(ACT + (size_t)(u.pm * BM + r) * DEXP + col0) = o; }
    }
};
struct EpiStore {
    static constexpr bool PERM = true;
    bf16_t* O; int ldc;
    __device__ __forceinline__ void operator()(const f32x4 (&acc)[2][2][4][2], const Unit& u, int wr, int wc, int fr, int fq) const {
        asm volatile("" : "+v"(fr), "+v"(fq));
        const int row0 = u.pm * BM + wr * 64 + fr; const int col0 = u.pn * BM + wc * 32 + 8 * fq;
#pragma unroll
        for (int ai = 0; ai < 2; ++ai)
#pragma unroll
            for (int m = 0; m < 4; ++m) { bf16_t* rowp = O + (size_t)(row0 + ai * HALF + m * 16) * ldc + col0;
#pragma unroll
                for (int bj = 0; bj < 2; ++bj) { const f32x4 v0 = acc[ai][bj][m][0], v1 = acc[ai][bj][m][1];
                    u32x4 w; w.x = cvt_pk_bf16(v0[0], v0[1]); w.y = cvt_pk_bf16(v0[2], v0[3]); w.z = cvt_pk_bf16(v1[0], v1[1]); w.w = cvt_pk_bf16(v1[2], v1[3]);
                    *(u32x4*)(rowp + bj * HALF) = w; } }
    }
};
}

#define XB_TMO      128
#define XB_XCNT(j)  (256  + 64 * (j))
#define XB_XSUB(j)  (1280 + 64 * (j))
#define XB_XGEN(j)  (2304 + 64 * (j))
#define XB_TOP      3328
#define XB_TOPGEN   3392
#define XCD_BAR_WORDS 3456
#define XB_SPIN_CAP (1u << 18)
__device__ __forceinline__ unsigned xb_ld(unsigned* p)              { return __hip_atomic_load(p, __ATOMIC_RELAXED, __HIP_MEMORY_SCOPE_AGENT); }
__device__ __forceinline__ unsigned xb_add(unsigned* p, unsigned v) { return __hip_atomic_fetch_add(p, v, __ATOMIC_RELAXED, __HIP_MEMORY_SCOPE_AGENT); }
__device__ __forceinline__ unsigned xb_xcc_id() { return (unsigned)__builtin_amdgcn_s_getreg((3 << 11) | 20) & 0xFu; }
#define XB_SPIN(cond, bar) do { unsigned _sp = 0; while (cond) { __builtin_amdgcn_s_sleep(1); \
    if ((++_sp & 255u) == 0u) { if (xb_ld(&(bar)[XB_TMO])) break; if (_sp > XB_SPIN_CAP) { atomicAdd(&(bar)[XB_TMO], 1u); break; } } } } while (0)
struct XcdBarrier { unsigned* bar; unsigned x; volatile LAS unsigned* st; };
__device__ __forceinline__ XcdBarrier xcd_barrier_post(unsigned* bar, volatile LAS unsigned* st) {
    XcdBarrier b; b.bar = bar; b.x = xb_xcc_id(); b.st = st;
    if (threadIdx.x == 0) (void)xb_add(&bar[XB_XCNT(b.x)], 1u);
    return b;
}
__device__ __forceinline__ void xcd_barrier_complete(unsigned* bar, unsigned x, unsigned& nloc, unsigned& nx) {
    const unsigned G = gridDim.x * gridDim.y * gridDim.z;
    unsigned sum, cnt, mine, sp = 0u;
    for (;;) {
        sum = 0u; cnt = 0u; mine = 0u;
#pragma unroll
        for (unsigned j = 0; j < 16; ++j) { const unsigned c = xb_ld(&bar[XB_XCNT(j)]); sum += c; cnt += (c > 0u) ? 1u : 0u; mine = (j == x) ? c : mine; }
        if (sum == G) break;
        __builtin_amdgcn_s_sleep(1);
        if ((++sp & 255u) == 0u) { if (xb_ld(&bar[XB_TMO])) break; if (sp > XB_SPIN_CAP) { atomicAdd(&bar[XB_TMO], 1u); break; } }
    }
    nloc = mine > 0u ? mine : 1u; nx = cnt > 0u ? cnt : 1u;
}
__device__ __forceinline__ void xcd_barrier(const XcdBarrier& b) {
    asm volatile("s_waitcnt vmcnt(0)" ::: "memory");
    __syncthreads();
    if (threadIdx.x == 0) {
        unsigned* bar = b.bar;
        __builtin_amdgcn_s_waitcnt(0);
        unsigned nloc = b.st[0], nx = b.st[1];
        if (nloc == 0u) { xcd_barrier_complete(bar, b.x, nloc, nx); b.st[0] = nloc; b.st[1] = nx; }
        const unsigned old = xb_add(&bar[XB_XSUB(b.x)], 1u);
        const unsigned gen = old / nloc;
        if (old + 1u == (gen + 1u) * nloc) {
            __builtin_amdgcn_fence(__ATOMIC_RELEASE, "agent");
            asm volatile("s_waitcnt vmcnt(0)" ::: "memory");
            const unsigned og = xb_add(&bar[XB_TOP], 1u);
            const unsigned tg = og / nx;
            if (og + 1u == (tg + 1u) * nx) xb_add(&bar[XB_TOPGEN], 1u);
            else XB_SPIN(xb_ld(&bar[XB_TOPGEN]) == tg, bar);
            __builtin_amdgcn_fence(__ATOMIC_ACQUIRE, "agent");
            xb_add(&bar[XB_XGEN(b.x)], 1u);
            asm volatile("s_waitcnt vmcnt(0)" ::: "memory");
        } else {
            XB_SPIN(xb_ld(&bar[XB_XGEN(b.x)]) == gen, bar);
            __builtin_amdgcn_fence(__ATOMIC_ACQUIRE, "agent");
            asm volatile("s_waitcnt vmcnt(0)" ::: "memory");
        }
    }
    __syncthreads();
}

constexpr int NWAVES = 8, NTHR = 512;
struct Frame {
    LAS unsigned char* lds;
    volatile LAS unsigned* MISC;
    unsigned* ctl;
    int tid, lane, wave, vcu, G;
    float* out; unsigned char* ws;
};
constexpr int PTAB_OFF = LDSCTL_OFF + 512;
__device__ __forceinline__ const float* inptr(const Frame& F, int i) {
    const LAS unsigned* p = (const LAS unsigned*)(F.lds + PTAB_OFF) + 2 * i;
    const unsigned lo = __builtin_amdgcn_readfirstlane(p[0]), hi = __builtin_amdgcn_readfirstlane(p[1]);
    return (const float*)(((unsigned long long)hi << 32) | lo);
}
#define F_X (inptr(F, 0))
#define F_C (inptr(F, 1))
#define F_WADA (inptr(F, 2))
#define F_BADA (inptr(F, 3))
#define F_NMIX (inptr(F, 4))
#define F_NFFN (inptr(F, 5))
#define F_WIN (inptr(F, 6))
#define F_WGK2 (inptr(F, 7))
#define F_BGK (inptr(F, 8))
#define F_QGAIN (inptr(F, 9))
#define F_KGAIN (inptr(F, 10))
#define F_GLAGAIN (inptr(F, 11))
#define F_WOUT (inptr(F, 12))
#define F_WRG (inptr(F, 13))
#define F_BRG (inptr(F, 14))
#define F_WRE (inptr(F, 15))
#define F_BRE (inptr(F, 16))
#define F_WGATE (inptr(F, 17))
#define F_WUP (inptr(F, 18))
#define F_WDOWN (inptr(F, 19))

__device__ __forceinline__ void p0_transpose_item(const float* W, int K, int N, bf16* WT, int k0, int n0, int drow0, LAS float* scr, int lane) {
#pragma unroll 8
    for (int i = 0; i < 32; ++i) { const int kk = 2 * i + (lane >> 5); scr[kk * 33 + (lane & 31)] = W[(size_t)(k0 + kk) * N + n0 + (lane & 31)]; }
    LDS_WAIT(); asm volatile("" ::: "memory");
    const int c = lane & 7;
#pragma unroll
    for (int j = 0; j < 4; ++j) { const int n = (lane >> 3) + 8 * j; const LAS float* s = scr + (8 * c) * 33 + n;
        u32x4 o; o.x = pk2(s[0 * 33], s[1 * 33]); o.y = pk2(s[2 * 33], s[3 * 33]); o.z = pk2(s[4 * 33], s[5 * 33]); o.w = pk2(s[6 * 33], s[7 * 33]);
        *(u32x4*)(WT + (size_t)(drow0 + n) * K + k0 + 8 * c) = o; }
    LDS_WAIT(); asm volatile("" ::: "memory");
}
__device__ __forceinline__ void p0_prologue(Frame& F) {
    LAS float* scr = (LAS float*)(F.lds + F.wave * 16384);
    const int gw = F.vcu * NWAVES + F.wave, NGW = F.G * NWAVES, lane = F.lane;
    constexpr int I_IN = 16 * 96, I_OUT = 16 * 32, I_G = NEXP * 16 * 8, I_D = NEXP * 4 * 32, I_LAYER = I_IN + I_OUT + 2 * I_G + I_D;
    for (int it = gw; it < NL * I_LAYER; it += NGW) {
        const int l = it / I_LAYER; int r = it - l * I_LAYER;
        if (r < I_IN) {
            const int kb = r / 96, nb = r % 96, n0 = nb * 32; int drow0 = n0;
            if (n0 < 1024) { const int sec = n0 >> 9, f = n0 & 511, head = f >> 6, bjp = (f >> 5) & 1; drow0 = sec * 512 + 256 * (head >> 2) + 128 * bjp + 32 * (head & 3); }
            p0_transpose_item(F_WIN + (size_t)l * DM * DIN, DM, DIN, (bf16*)(F.ws + WS_WIN) + (size_t)l * PROJW * DM, kb * 64, n0, drow0, scr, lane); continue; }
        r -= I_IN;
        if (r < I_OUT) { const int kb = r / 32, nb = r % 32;
            p0_transpose_item(F_WOUT + (size_t)l * DM * DM, DM, DM, (bf16*)(F.ws + WS_WOUT) + (size_t)l * DM * DM, kb * 64, nb * 32, nb * 32, scr, lane); continue; }
        r -= I_OUT;
        if (r < 2 * I_G) { const int up = r / I_G; r -= up * I_G; const int e = r / 128, q = r % 128, kb = q / 8, nb = q % 8, n0 = nb * 32;
            const float* W = (up ? F_WUP : F_WGATE) + ((size_t)l * NEXP + e) * DM * DEXP;
            bf16* WT = (bf16*)(F.ws + WS_W1) + ((size_t)l * NEXP + e) * 512 * DM;
            p0_transpose_item(W, DM, DEXP, WT, kb * 64, n0, 256 * (n0 >> 7) + 128 * up + (n0 & 127), scr, lane); continue; }
        r -= 2 * I_G;
        { const int e = r / 128, q = r % 128, kb = q / 32, nb = q % 32;
            p0_transpose_item(F_WDOWN + ((size_t)l * NEXP + e) * DEXP * DM, DEXP, DM, (bf16*)(F.ws + WS_W2) + ((size_t)l * NEXP + e) * DM * DEXP, kb * 64, nb * 32, nb * 32, scr, lane); }
    }
    float* mod = (float*)(F.ws + WS_MOD);
    for (int idx = F.vcu * NTHR + F.tid; idx < NL * NMOD * DM; idx += F.G * NTHR) {
        const int l = idx / (NMOD * DM), j = idx - l * (NMOD * DM);
        float a[NB];
#pragma unroll
        for (int b = 0; b < NB; ++b) a[b] = 0.f;
        const float* w = F_WADA + (size_t)l * DM * NMOD * DM + j;
        for (int k = 0; k < DM; ++k) { const float wv = w[(size_t)k * NMOD * DM];
#pragma unroll
            for (int b = 0; b < NB; ++b) a[b] += siluf(F_C[b * DM + k]) * wv; }
        const float bias = F_BADA[idx];
#pragma unroll
        for (int b = 0; b < NB; ++b) mod[((size_t)l * NB + b) * NMOD * DM + j] = a[b] + bias;
    }
}

__device__ __forceinline__ void tile_bases(Frame& F, int l) {
    LAS int* tb = (LAS int*)(F.lds + LDSCTL_OFF);
    __syncthreads();
    if (F.tid == 0) { int s = 0; for (int e = 0; e < NEXP; ++e) { tb[e] = s; s += ((int)F.ctl[CW_CNT + l * 64 + e] + 255) >> 8; } tb[NEXP] = s; }
    __syncthreads();
}

__device__ __forceinline__ void phase_norm_a(Frame& F, int l) {
    const int gw = F.vcu * NWAVES + F.wave, NGW = F.G * NWAVES, lane = F.lane;
    const float* mod = (const float*)(F.ws + WS_MOD);
    if (l > 0) tile_bases(F, l - 1);
    const LAS int* tb = (const LAS int*)(F.lds + LDSCTL_OFF);
    const int* toke = (const int*)(F.ws + WS_TOKE); const int* tokp = (const int*)(F.ws + WS_TOKP);
    const bf16* Y = (const bf16*)(F.ws + WS_Y);
    bf16* H = (bf16*)(F.ws + WS_H); float* GLR = (float*)(F.ws + WS_GLR);
    for (int t = gw; t < NTOK; t += NGW) {
        const int b = t / SEQ;
        f32x4 v[4];
        const float* xr = (l == 0 ? F_X : F.out) + (size_t)t * DM;
#pragma unroll
        for (int j = 0; j < 4; ++j) v[j] = *(const f32x4*)(xr + 4 * lane + 256 * j);
        if (l > 0) {
            const float* gf = mod + ((size_t)(l - 1) * NB + b) * NMOD * DM + 5 * DM;
            const int e0 = toke[2 * t], e1 = toke[2 * t + 1];
            const size_t s0 = (size_t)tb[e0] * 256 + tokp[2 * t], s1 = (size_t)tb[e1] * 256 + tokp[2 * t + 1];
#pragma unroll
            for (int j = 0; j < 4; ++j) { const int c = 4 * lane + 256 * j;
                const u32x2 y0 = *(const u32x2*)(Y + s0 * DM + c), y1 = *(const u32x2*)(Y + s1 * DM + c); const f32x4 g = *(const f32x4*)(gf + c);
                v[j][0] += g[0] * (bflo(y0.x) + bflo(y1.x)); v[j][1] += g[1] * (bfhi(y0.x) + bfhi(y1.x));
                v[j][2] += g[2] * (bflo(y0.y) + bflo(y1.y)); v[j][3] += g[3] * (bfhi(y0.y) + bfhi(y1.y));
                *(f32x4*)(F.out + (size_t)t * DM + c) = v[j]; }
        }
        if (l == NL) continue;
        float ss = 0.f;
#pragma unroll
        for (int j = 0; j < 4; ++j) ss += (v[j][0] * v[j][0] + v[j][1] * v[j][1]) + (v[j][2] * v[j][2] + v[j][3] * v[j][3]);
        const float rstd = 1.f / sqrtf(wave_sum(ss) * (1.f / DM) + EPS);
        const float* mrow = mod + ((size_t)l * NB + b) * NMOD * DM;
        float glr[GRANK];
#pragma unroll
        for (int r = 0; r < GRANK; ++r) glr[r] = 0.f;
#pragma unroll
        for (int j = 0; j < 4; ++j) { const int c = 4 * lane + 256 * j;
            const f32x4 gn = *(const f32x4*)(F_NMIX + l * DM + c), sh = *(const f32x4*)(mrow + c), sc = *(const f32x4*)(mrow + DM + c);
            f32x4 h;
#pragma unroll
            for (int i = 0; i < 4; ++i) h[i] = v[j][i] * rstd * gn[i] * (1.f + sc[i]) + sh[i];
            u32x2 o; o.x = pk2(h[0], h[1]); o.y = pk2(h[2], h[3]);
            *(u32x2*)(H + (size_t)t * DM + c) = o;
#pragma unroll
            for (int i = 0; i < 4; ++i) { const float* wl = F_WIN + ((size_t)l * DM + c + i) * DIN + PROJW;
#pragma unroll
                for (int r4 = 0; r4 < 4; ++r4) { const f32x4 w = *(const f32x4*)(wl + 4 * r4);
                    glr[4 * r4] += h[i] * w[0]; glr[4 * r4 + 1] += h[i] * w[1]; glr[4 * r4 + 2] += h[i] * w[2]; glr[4 * r4 + 3] += h[i] * w[3]; } }
        }
#pragma unroll
        for (int r = 0; r < GRANK; ++r) glr[r] = wave_sum(glr[r]);
        if (lane == 0) {
#pragma unroll
            for (int r4 = 0; r4 < 4; ++r4) *(f32x4*)(GLR + (size_t)t * GRANK + 4 * r4) = (f32x4){glr[4 * r4], glr[4 * r4 + 1], glr[4 * r4 + 2], glr[4 * r4 + 3]};
        }
    }
}

__device__ __forceinline__ void phase_norm_e(Frame& F, int l) {
    const int gw = F.vcu * NWAVES + F.wave, NGW = F.G * NWAVES, lane = F.lane;
    const float* mod = (const float*)(F.ws + WS_MOD);
    int* toke = (int*)(F.ws + WS_TOKE); int* tokp = (int*)(F.ws + WS_TOKP);
    int* tokof = (int*)(F.ws + WS_TOKOF); float* slotw = (float*)(F.ws + WS_SLOTW);
    bf16* H = (bf16*)(F.ws + WS_H);
    unsigned* cnt = F.ctl + CW_CNT + l * 64;
    for (int t = gw; t < NTOK; t += NGW) {
        const int b = t / SEQ;
        f32x4 v[4];
        const float* xr = F.out + (size_t)t * DM;
#pragma unroll
        for (int j = 0; j < 4; ++j) v[j] = *(const f32x4*)(xr + 4 * lane + 256 * j);
        float ss = 0.f;
#pragma unroll
        for (int j = 0; j < 4; ++j) ss += (v[j][0] * v[j][0] + v[j][1] * v[j][1]) + (v[j][2] * v[j][2] + v[j][3] * v[j][3]);
        const float rstd = 1.f / sqrtf(wave_sum(ss) * (1.f / DM) + EPS);
        const float* mrow = mod + ((size_t)l * NB + b) * NMOD * DM;
        float lg[36];
#pragma unroll
        for (int r = 0; r < 36; ++r) lg[r] = 0.f;
#pragma unroll
        for (int j = 0; j < 4; ++j) { const int c = 4 * lane + 256 * j;
            const f32x4 gn = *(const f32x4*)(F_NFFN + l * DM + c), sh = *(const f32x4*)(mrow + 3 * DM + c), sc = *(const f32x4*)(mrow + 4 * DM + c);
            f32x4 h;
#pragma unroll
            for (int i = 0; i < 4; ++i) h[i] = v[j][i] * rstd * gn[i] * (1.f + sc[i]) + sh[i];
            u32x2 o; o.x = pk2(h[0], h[1]); o.y = pk2(h[2], h[3]);
            *(u32x2*)(H + (size_t)t * DM + c) = o;
#pragma unroll
            for (int i = 0; i < 4; ++i) {
                const f32x4 wg = *(const f32x4*)(F_WRG + ((size_t)l * DM + c + i) * NGRP);
                lg[0] += h[i] * wg[0]; lg[1] += h[i] * wg[1]; lg[2] += h[i] * wg[2]; lg[3] += h[i] * wg[3];
                const float* we = F_WRE + ((size_t)l * DM + c + i) * NEXP;
#pragma unroll
                for (int r4 = 0; r4 < 8; ++r4) { const f32x4 w = *(const f32x4*)(we + 4 * r4);
                    lg[4 + 4 * r4] += h[i] * w[0]; lg[5 + 4 * r4] += h[i] * w[1]; lg[6 + 4 * r4] += h[i] * w[2]; lg[7 + 4 * r4] += h[i] * w[3]; } }
        }
#pragma unroll
        for (int r = 0; r < 36; ++r) lg[r] = wave_sum(lg[r]);
        if (lane == 0) {
            float gl[4]; int gi = 0;
#pragma unroll
            for (int g = 0; g < 4; ++g) gl[g] = lg[g] + F_BRG[l * NGRP + g];
            float gmax = gl[0];
#pragma unroll
            for (int g = 1; g < 4; ++g) if (gl[g] > gmax) { gmax = gl[g]; gi = g; }
            float den = 0.f;
#pragma unroll
            for (int g = 0; g < 4; ++g) den += __expf(gl[g] - gmax);
            const float gw_ = 1.f / den;
            float el[8];
#pragma unroll
            for (int e = 0; e < 8; ++e) el[e] = 0.f;
#pragma unroll
            for (int g = 0; g < 4; ++g) if (g == gi) {
#pragma unroll
                for (int e = 0; e < 8; ++e) el[e] = lg[4 + 8 * g + e] + F_BRE[l * NEXP + 8 * g + e]; }
            int i0 = 0; float l0 = el[0];
#pragma unroll
            for (int e = 1; e < 8; ++e) if (el[e] > l0) { l0 = el[e]; i0 = e; }
            int i1 = -1; float l1 = -3.0e38f;
#pragma unroll
            for (int e = 0; e < 8; ++e) if (e != i0 && el[e] > l1) { l1 = el[e]; i1 = e; }
            const float ex = __expf(l1 - l0); const float w0 = gw_ / (1.f + ex), w1 = gw_ * ex / (1.f + ex);
            const int e0 = gi * 8 + i0, e1 = gi * 8 + i1;
            const int p0 = (int)atomicAdd(&cnt[e0], 1u), p1 = (int)atomicAdd(&cnt[e1], 1u);
            toke[2 * t] = e0; toke[2 * t + 1] = e1; tokp[2 * t] = p0; tokp[2 * t + 1] = p1;
            tokof[(size_t)e0 * NTOK + p0] = t; tokof[(size_t)e1 * NTOK + p1] = t;
            slotw[(size_t)e0 * NTOK + p0] = w0; slotw[(size_t)e1 * NTOK + p1] = w1;
        }
    }
}
__device__ __forceinline__ void phase_pad_lists(Frame& F, int l) {
    int* tokof = (int*)(F.ws + WS_TOKOF); float* slotw = (float*)(F.ws + WS_SLOTW);
    for (int e = F.vcu; e < NEXP; e += F.G) { const int c = (int)F.ctl[CW_CNT + l * 64 + e]; const int cp = (c + 255) & ~255;
        for (int i = c + F.tid; i < cp; i += NTHR) { tokof[(size_t)e * NTOK + i] = 0; slotw[(size_t)e * NTOK + i] = 0.f; } }
}

__device__ __forceinline__ void phase_logdecay(Frame& F, int l) {
    const float* GLR = (const float*)(F.ws + WS_GLR); float* LG = (float*)(F.ws + WS_LG);
    for (int idx = F.vcu * NTHR + F.tid; idx < NTOK * GKW; idx += F.G * NTHR) {
        const int t = idx >> 8, c = idx & 255;
        float p = F_BGK[l * GKW + c];
#pragma unroll
        for (int r = 0; r < GRANK; ++r) p += GLR[(size_t)t * GRANK + r] * F_WGK2[((size_t)l * GRANK + r) * GKW + c];
        const float sp = fmaxf(-p, 0.f) + log1pf(__expf(-fabsf(p)));
        LG[idx] = -sp * (1.f / 16.f);
    }
}
__device__ __forceinline__ void phase_sb_naive(Frame& F) {
    const bf16* P = (const bf16*)(F.ws + WS_PROJ); bf16* MIX = (bf16*)(F.ws + WS_MIX);
    for (int idx = F.vcu * NTHR + F.tid; idx < NB * SBH * SEQ; idx += F.G * NTHR) {
        const int q = idx & (SEQ - 1), h = (idx >> 12) & 7, b = idx >> 15;
        const size_t trow = (size_t)b * SEQ + q;
        float qv[64], o[64];
#pragma unroll
        for (int c = 0; c < 8; ++c) { const u32x4 w = *(const u32x4*)(P + trow * PROJW + PC_Q + h * 64 + 8 * c);
            qv[8 * c] = bflo(w.x); qv[8 * c + 1] = bfhi(w.x); qv[8 * c + 2] = bflo(w.y); qv[8 * c + 3] = bfhi(w.y); qv[8 * c + 4] = bflo(w.z); qv[8 * c + 5] = bfhi(w.z); qv[8 * c + 6] = bflo(w.w); qv[8 * c + 7] = bfhi(w.w); }
#pragma unroll
        for (int d = 0; d < 64; ++d) o[d] = 0.f;
        float accl = 0.f;
        for (int s = q - 1; s >= 0; --s) {
            const bf16* kr = P + ((size_t)b * SEQ + s) * PROJW + PC_K + h * 64;
            float z = 0.f;
#pragma unroll
            for (int c = 0; c < 8; ++c) { const u32x4 w = *(const u32x4*)(kr + 8 * c);
                z += qv[8 * c] * bflo(w.x) + qv[8 * c + 1] * bfhi(w.x) + qv[8 * c + 2] * bflo(w.y) + qv[8 * c + 3] * bfhi(w.y) + qv[8 * c + 4] * bflo(w.z) + qv[8 * c + 5] * bfhi(w.z) + qv[8 * c + 6] * bflo(w.w) + qv[8 * c + 7] * bfhi(w.w); }
            const float lf = -(fmaxf(z, 0.f) + __log2f(1.f + exp2f(-fabsf(z))));
            const float w_ = exp2f(z + lf + accl);
            const bf16* vr = P + ((size_t)b * SEQ + s) * PROJW + PC_V + h * 64;
#pragma unroll
            for (int c = 0; c < 8; ++c) { const u32x4 w = *(const u32x4*)(vr + 8 * c);
                o[8 * c] += w_ * bflo(w.x); o[8 * c + 1] += w_ * bfhi(w.x); o[8 * c + 2] += w_ * bflo(w.y); o[8 * c + 3] += w_ * bfhi(w.y); o[8 * c + 4] += w_ * bflo(w.z); o[8 * c + 5] += w_ * bfhi(w.z); o[8 * c + 6] += w_ * bflo(w.w); o[8 * c + 7] += w_ * bfhi(w.w); }
            accl += lf;
            if (accl < -150.f) break;
        }
#pragma unroll
        for (int c = 0; c < 8; ++c) { u32x4 w; w.x = pk2(o[8 * c], o[8 * c + 1]); w.y = pk2(o[8 * c + 2], o[8 * c + 3]); w.z = pk2(o[8 * c + 4], o[8 * c + 5]); w.w = pk2(o[8 * c + 6], o[8 * c + 7]);
            *(u32x4*)(MIX + trow * DM + h * 64 + 8 * c) = w; }
    }
}
__device__ __forceinline__ void phase_gla_naive(Frame& F) {
    const bf16* P = (const bf16*)(F.ws + WS_PROJ); const float* LG = (const float*)(F.ws + WS_LG); float* OB = (float*)(F.ws + WS_OB);
    for (int idx = F.vcu * NTHR + F.tid; idx < NB * GH * GDV; idx += F.G * NTHR) {
        const int vv = idx & 127, g = (idx >> 7) & 3, b = idx >> 9;
        float S[64];
#pragma unroll
        for (int d = 0; d < 64; ++d) S[d] = 0.f;
        for (int t = 0; t < SEQ; ++t) {
            const size_t trow = (size_t)b * SEQ + t;
            const float vt = bf2f(P[trow * PROJW + PC_GV + g * GDV + vv]);
            float o = 0.f;
#pragma unroll
            for (int c = 0; c < 8; ++c) { const u32x4 kw = *(const u32x4*)(P + trow * PROJW + PC_GK + g * 64 + 8 * c), qw = *(const u32x4*)(P + trow * PROJW + PC_GQ + g * 64 + 8 * c);
                const f32x4 l0 = *(const f32x4*)(LG + trow * GKW + g * 64 + 8 * c), l1 = *(const f32x4*)(LG + trow * GKW + g * 64 + 8 * c + 4);
                S[8 * c]     = __expf(l0[0]) * S[8 * c]     + bflo(kw.x) * vt; o += bflo(qw.x) * S[8 * c];
                S[8 * c + 1] = __expf(l0[1]) * S[8 * c + 1] + bfhi(kw.x) * vt; o += bfhi(qw.x) * S[8 * c + 1];
                S[8 * c + 2] = __expf(l0[2]) * S[8 * c + 2] + bflo(kw.y) * vt; o += bflo(qw.y) * S[8 * c + 2];
                S[8 * c + 3] = __expf(l0[3]) * S[8 * c + 3] + bfhi(kw.y) * vt; o += bfhi(qw.y) * S[8 * c + 3];
                S[8 * c + 4] = __expf(l1[0]) * S[8 * c + 4] + bflo(kw.z) * vt; o += bflo(qw.z) * S[8 * c + 4];
                S[8 * c + 5] = __expf(l1[1]) * S[8 * c + 5] + bfhi(kw.z) * vt; o += bfhi(qw.z) * S[8 * c + 5];
                S[8 * c + 6] = __expf(l1[2]) * S[8 * c + 6] + bflo(kw.w) * vt; o += bflo(qw.w) * S[8 * c + 6];
                S[8 * c + 7] = __expf(l1[3]) * S[8 * c + 7] + bfhi(kw.w) * vt; o += bfhi(qw.w) * S[8 * c + 7];
                asm volatile("" ::: "memory"); }
            OB[trow * GVW + g * GDV + vv] = o;
        }
    }
}
__device__ __forceinline__ void phase_gla_out(Frame& F, int l) {
    const bf16* P = (const bf16*)(F.ws + WS_PROJ); const float* OB = (const float*)(F.ws + WS_OB); bf16* MIX = (bf16*)(F.ws + WS_MIX);
    const int gw = F.vcu * NWAVES + F.wave, NGW = F.G * NWAVES, lane = F.lane;
    for (int it = gw; it < NTOK * GH; it += NGW) {
        const int t = it >> 2, g = it & 3;
        const f32x2 o = *(const f32x2*)(OB + (size_t)t * GVW + g * GDV + 2 * lane);
        const float rstd = 1.f / sqrtf(wave_sum(o[0] * o[0] + o[1] * o[1]) * (1.f / GDV) + EPS);
        const unsigned gr = *(const unsigned*)(P + (size_t)t * PROJW + PC_GR + g * GDV + 2 * lane);
        const f32x2 gn = *(const f32x2*)(F_GLAGAIN + l * GDV + 2 * lane);
        *(unsigned*)(MIX + (size_t)t * DM + SBW + g * GDV + 2 * lane) = pk2(o[0] * rstd * gn[0] * bflo(gr), o[1] * rstd * gn[1] * bfhi(gr));
    }
}

constexpr int PH_PER_LAYER = 10, PH_TOTAL = 2 + NL * PH_PER_LAYER;
struct Args { const float* in[20]; float* out; unsigned char* ws; int ph_lo, ph_hi, use_bar, pad; };
template <unsigned MASK>
__global__ void __launch_bounds__(NTHR, 2) fwd_kernel(Args args) {
    extern __shared__ __attribute__((aligned(16))) unsigned char lds[];
    Frame F;
    F.lds = (LAS unsigned char*)lds;
    F.MISC = (volatile LAS unsigned*)(F.lds + MISC_OFF);
    F.tid = threadIdx.x; F.lane = F.tid & 63; F.wave = __builtin_amdgcn_readfirstlane(F.tid >> 6);
    F.G = gridDim.x; { const int bx = blockIdx.x; F.vcu = (F.G % 8 == 0) ? (bx % 8) * (F.G / 8) + bx / 8 : bx; }
    F.out = args.out; F.ws = args.ws; F.ctl = (unsigned*)(args.ws + WS_CTL);
    for (int u = F.tid; u < (LDS_BYTES - LDSCTL_OFF) / 4; u += NTHR) ((LAS unsigned*)(F.lds + LDSCTL_OFF))[u] = 0u;
    __syncthreads();
    if (F.tid < 20) { const unsigned long long pv = (unsigned long long)args.in[F.tid]; LAS unsigned* p = (LAS unsigned*)(F.lds + PTAB_OFF) + 2 * F.tid; p[0] = (unsigned)pv; p[1] = (unsigned)(pv >> 32); }
    __syncthreads();
    XcdBarrier bar; bar.bar = F.ctl + CW_BAR; bar.x = 0; bar.st = nullptr;
    if (args.use_bar) bar = xcd_barrier_post(F.ctl + CW_BAR, F.MISC + 8);
    const int lo = args.ph_lo, hi = args.ph_hi;
#define INB(k, bit) ((((MASK) >> (bit)) & 1u) && lo <= (k) && (k) < hi)
#define SEAM(k) do { if (MASK == 0xFFFu && lo <= (k) && (k) + 1 < hi) xcd_barrier(bar); } while (0)
    if (INB(0, 10)) { p0_prologue(F); SEAM(0); }
    for (int l = 0; l < NL; ++l) {
        const int pb = 1 + l * PH_PER_LAYER;
        const float* mod = (const float*)(F.ws + WS_MOD) + (size_t)l * NB * NMOD * DM;
        if (INB(pb + 0, 0)) { phase_norm_a(F, l); SEAM(pb + 0); }
        if (INB(pb + 1, 1)) {
            pg8::Gemm g{(const bf16*)(F.ws + WS_H), (const bf16*)(F.ws + WS_WIN) + (size_t)l * PROJW * DM, DM, nullptr};
            pg8::StaticOrder S; S.init(NTOK, PROJW, F.G, (int)blockIdx.x);
            pg8::EpiProj E{(bf16*)(F.ws + WS_PROJ), F_QGAIN + l * SBD, F_KGAIN + l * SBD};
            pg8::gemm_phase<pg8::EpiProj, pg8::StaticOrder, false, true, true>(F.lds, g, S, E);
            SEAM(pb + 1);
        }
        if (INB(pb + 2, 2)) { phase_logdecay(F, l); phase_sb_naive(F); SEAM(pb + 2); }
        if (INB(pb + 3, 3)) { phase_gla_naive(F); SEAM(pb + 3); }
        if (INB(pb + 4, 4)) { phase_gla_out(F, l); SEAM(pb + 4); }
        if (INB(pb + 5, 5)) {
            pg8::Gemm g{(const bf16*)(F.ws + WS_MIX), (const bf16*)(F.ws + WS_WOUT) + (size_t)l * DM * DM, DM, nullptr};
            pg8::StaticOrder S; S.init(NTOK, DM, F.G, (int)blockIdx.x);
            pg8::EpiResid E{l == 0 ? F_X : F.out, F.out, mod + 2 * DM};
            pg8::gemm_phase<pg8::EpiResid, pg8::StaticOrder, false, true, true>(F.lds, g, S, E);
            SEAM(pb + 5);
        }
        if (INB(pb + 6, 6)) { phase_norm_e(F, l); SEAM(pb + 6); }
        if (INB(pb + 7, 7)) { phase_pad_lists(F, l); SEAM(pb + 7); }
        if (INB(pb + 8, 8)) {
            tile_bases(F, l);
            pg8::Gemm g{(const bf16*)(F.ws + WS_H), (const bf16*)(F.ws + WS_W1) + (size_t)l * NEXP * 512 * DM, DM, (const int*)(F.ws + WS_TOKOF)};
            pg8::GroupedOrder S{(const LAS int*)(F.lds + LDSCTL_OFF), 2, F.G, (int)blockIdx.x};
            pg8::EpiMoeAct E{(bf16*)(F.ws + WS_ACT), (const float*)(F.ws + WS_SLOTW)};
            pg8::gemm_phase<pg8::EpiMoeAct, pg8::GroupedOrder, true, true, true>(F.lds, g, S, E);
            SEAM(pb + 8);
        }
        if (INB(pb + 9, 9)) {
            tile_bases(F, l);
            pg8::Gemm g{(const bf16*)(F.ws + WS_ACT), (const bf16*)(F.ws + WS_W2) + (size_t)l * NEXP * DM * DEXP, DEXP, nullptr};
            pg8::GroupedOrder S{(const LAS int*)(F.lds + LDSCTL_OFF), 4, F.G, (int)blockIdx.x};
            pg8::EpiStore E{(bf16*)(F.ws + WS_Y), DM};
            pg8::gemm_phase<pg8::EpiStore, pg8::GroupedOrder, false, true, true>(F.lds, g, S, E);
            SEAM(pb + 9);
        }
    }
    if (INB(PH_TOTAL - 1, 11)) phase_norm_a(F, NL);
#undef INB
#undef SEAM
}

#ifndef N_LAUNCH_MODE
#define N_LAUNCH_MODE 0
#endif
static const void* kfun(int j) {
    switch (j) {
        case 0: return (const void*)fwd_kernel<1u << 0>; case 1: return (const void*)fwd_kernel<1u << 1>; case 2: return (const void*)fwd_kernel<1u << 2>; case 3: return (const void*)fwd_kernel<1u << 3>;
        case 4: return (const void*)fwd_kernel<1u << 4>; case 5: return (const void*)fwd_kernel<1u << 5>; case 6: return (const void*)fwd_kernel<1u << 6>; case 7: return (const void*)fwd_kernel<1u << 7>;
        case 8: return (const void*)fwd_kernel<1u << 8>; case 9: return (const void*)fwd_kernel<1u << 9>; case 10: return (const void*)fwd_kernel<1u << 10>; case 11: return (const void*)fwd_kernel<1u << 11>;
#if N_LAUNCH_MODE == 1
        default: return (const void*)fwd_kernel<0xFFFu>;
#else
        default: return (const void*)fwd_kernel<1u << 11>;
#endif
    }
}
extern "C" void kernel_launch(void* const* d_in, const int* in_sizes, int n_in, void* d_out, int out_size, void* d_ws, size_t ws_size, hipStream_t stream) {
    static int grid = 0;
    if (grid == 0) {
        if (n_in != 20 || out_size != NTOK * DM || ws_size < WS_END) { fprintf(stderr, "kernel_launch: unexpected sizes (n_in %d, out %d, ws %zu)\n", n_in, out_size, ws_size); grid = -1; return; }
        int dev = 0, cus = 0;
        if (hipGetDevice(&dev) != hipSuccess || hipDeviceGetAttribute(&cus, hipDeviceAttributeMultiprocessorCount, dev) != hipSuccess) { grid = -1; return; }
        for (int j = 0; j < 13; ++j) if (hipFuncSetAttribute(kfun(j), hipFuncAttributeMaxDynamicSharedMemorySize, LDS_BYTES) != hipSuccess) { fprintf(stderr, "kernel_launch: hipFuncSetAttribute failed\n"); grid = -1; return; }
        (void)hipGetLastError();
        grid = cus;
    }
    if (grid < 0) return;
    (void)hipMemsetAsync((char*)d_ws + WS_CTL, 0, CTL_ZERO_BYTES, stream);
    Args a{};
    for (int i = 0; i < 20; ++i) a.in[i] = (const float*)d_in[i];
    a.out = (float*)d_out; a.ws = (unsigned char*)d_ws; a.pad = 0;
    if (N_LAUNCH_MODE == 1) {
        a.ph_lo = 0; a.ph_hi = PH_TOTAL; a.use_bar = 1;
        void* av[] = {&a};
        (void)hipLaunchKernel(kfun(12), dim3(grid), dim3(NTHR), av, LDS_BYTES, stream);
    } else {
        for (int p = 0; p < PH_TOTAL; ++p) { a.ph_lo = p; a.ph_hi = p + 1; a.use_bar = 0;
            const int j = (p == 0) ? 10 : (p == PH_TOTAL - 1 ? 11 : (p - 1) % PH_PER_LAYER);
            void* av[] = {&a};
            (void)hipLaunchKernel(kfun(j), dim3(grid), dim3(NTHR), av, LDS_BYTES, stream); }
    }
}
```

```cpp
#include <hip/hip_runtime.h>
#include <cstdio>
#include <cstdint>

#define GAS __attribute__((address_space(1)))
#define LAS __attribute__((address_space(3)))
typedef unsigned short bf16;
typedef unsigned short bf16_t;
typedef short bf16x8 __attribute__((ext_vector_type(8)));
typedef float f32x4 __attribute__((ext_vector_type(4)));
typedef float f32x2 __attribute__((ext_vector_type(2)));
typedef unsigned u32x4 __attribute__((ext_vector_type(4)));
typedef unsigned u32x2 __attribute__((ext_vector_type(2)));
typedef GAS unsigned gu32;

constexpr int DM = 1024, NB = 8, SEQ = 4096, NL = 4, NTOK = NB * SEQ;
constexpr int SBW = 512, SBH = 8, SBD = 64;
constexpr int GH = 4, GDK = 64, GDV = 128, GKW = 256, GVW = 512, GRANK = 16;
constexpr int DIN = 3088, PROJW = 3072;
constexpr int NGRP = 4, EPG = 8, NEXP = 32, DEXP = 256, NMOD = 6;
constexpr float EPS = 1e-6f;
constexpr float LOG2E = 1.4426950408889634f;
constexpr float QSCALE = 0.125f * LOG2E;
constexpr int PC_Q = 0, PC_K = 512, PC_V = 1024, PC_GQ = 1536, PC_GK = 1792, PC_GV = 2048, PC_GR = 2560;
constexpr int MAXSLOT = 73728;

constexpr size_t MiB = 1u << 20;
constexpr size_t WS_CTL = 0, CTL_ZERO_BYTES = 1 * MiB;
constexpr size_t WS_MOD = 1 * MiB;
constexpr size_t WS_WSM = 2 * MiB;
constexpr size_t WS_WIN = 4 * MiB;
constexpr size_t WS_WOUT = 28 * MiB;
constexpr size_t WS_W1 = 36 * MiB;
constexpr size_t WS_W2 = 164 * MiB;
constexpr size_t WS_H = 228 * MiB;
constexpr size_t WS_MIX = 292 * MiB;
constexpr size_t WS_PROJ = 356 * MiB;
constexpr size_t WS_ACT = 356 * MiB;
constexpr size_t WS_Y = 400 * MiB;
constexpr size_t WS_GLR = 548 * MiB;
constexpr size_t WS_LG = 550 * MiB;
constexpr size_t WS_OB = 582 * MiB;
constexpr size_t WS_GVT = 550 * MiB;
constexpr size_t WS_ST = 582 * MiB;
constexpr size_t WS_DECAY = 646 * MiB + 512 * 1024;
constexpr size_t WS_TOKE = 646 * MiB;
constexpr size_t WS_TOKP = WS_TOKE + 256 * 1024;
constexpr size_t WS_TOKW = WS_TOKP + 256 * 1024;
constexpr size_t WS_TOKOF = 647 * MiB;
constexpr size_t WS_SLOTW = 651 * MiB;
constexpr size_t WS_END = 655 * MiB;
static_assert(WS_ACT + (size_t)MAXSLOT * DEXP * 2 <= WS_Y && WS_Y + (size_t)MAXSLOT * DM * 2 <= WS_PROJ + (size_t)NTOK * PROJW * 2 && WS_PROJ + (size_t)NTOK * PROJW * 2 <= WS_GLR, "ws map");
constexpr int CW_TMO = 0;
constexpr int CW_BAR = 4096;
constexpr int CW_CNT = 16384;

constexpr int RING_BYTES = 131072;
constexpr int GLA_WL = 17408;
constexpr int LDSCTL_OFF = 8 * GLA_WL, MISC_OFF = LDSCTL_OFF + 320;
constexpr int LDS_BYTES = 147456;

#define RLX_AGENT __ATOMIC_RELAXED, __HIP_MEMORY_SCOPE_AGENT
#define LDS_WAIT() asm volatile("s_waitcnt lgkmcnt(0)" ::: "memory")
#define VM_WAIT() asm volatile("s_waitcnt vmcnt(0)" ::: "memory")
__device__ __forceinline__ unsigned f2bf(float f) { unsigned u = __builtin_bit_cast(unsigned, f); return (u + 0x7fffu + ((u >> 16) & 1u)) >> 16; }
__device__ __forceinline__ unsigned pk2(float lo, float hi) { return f2bf(lo) | (f2bf(hi) << 16); }
__device__ __forceinline__ float bf2f(unsigned short b) { return __builtin_bit_cast(float, (unsigned)b << 16); }
__device__ __forceinline__ float bflo(unsigned w) { return __builtin_bit_cast(float, w << 16); }
__device__ __forceinline__ float bfhi(unsigned w) { return __builtin_bit_cast(float, w & 0xffff0000u); }
__device__ __forceinline__ float siluf(float v) { return v / (1.f + __expf(-v)); }
__device__ __forceinline__ float wave_sum(float v) {
#pragma unroll
    for (int o = 1; o < 64; o <<= 1) v += __shfl_xor(v, o);
    return v;
}

namespace pg8 {
constexpr int BM = 256, BK = 64, HALF = 128, HTB = HALF * BK * 2, NXCD = 8, WGM = 8;
__host__ __device__ __forceinline__ int lds_byte(int r, int c) { const int st = (r >> 4) * 2 + (c >> 5), rr = r & 15, cc = c & 31, ob = rr * 64 + cc * 2; return st * 1024 + (ob ^ (((ob >> 9) & 1) << 5)); }
__host__ __device__ __forceinline__ void stage_rc(int b, int& R, int& C) { const int st = b / 1024, sb = b % 1024, swz = sb ^ (((sb >> 9) & 1) << 5); R = (st >> 1) * 16 + swz / 64; C = (st & 1) * 32 + (swz % 64) / 2; }
__host__ __device__ __forceinline__ int perm32(int rho) { const int n = rho >> 4, i = rho & 15; return 8 * (i >> 2) + 4 * n + (i & 3); }

struct Unit { int pm, pn, pb, aux; };
struct Gemm { const bf16_t* A; const bf16_t* Bt; int K; const int* rowmap; };

struct StaticOrder {
    int nM, nN, nwg, G, c;
    int skip_from, skip_n;
    __device__ void init(int M, int N, int G_, int c_) { nM = M / BM; nN = N / BM; nwg = nM * nN; G = G_; c = c_; skip_from = 1 << 30; skip_n = 0; }
    __device__ bool next(int i, Unit& u) const {
        const long L = (long)i * G + c; if (L >= nwg) return false;
        int wgid = (int)L; { const int q = nwg / NXCD, r = nwg % NXCD, xcd = wgid % NXCD, off = wgid / NXCD; wgid = (xcd < r ? xcd * (q + 1) : r * (q + 1) + (xcd - r) * q) + off; }
        const int nig = WGM * nN, gid = wgid / nig, fm = gid * WGM, gsz = (nM - fm) < WGM ? (nM - fm) : WGM;
        u.pm = fm + ((wgid % nig) % gsz); u.pn = (wgid % nig) / gsz; if (u.pn >= skip_from) u.pn += skip_n; u.pb = u.pn; u.aux = 0; return true;
    }
};
struct GroupedOrder {
    const LAS int* tb; int nN, G, c;
    __device__ bool next(int i, Unit& u) const {
        const int L = i * G + c; const int mt = L / nN, ntile = L - mt * nN;
        if (mt >= __builtin_amdgcn_readfirstlane(tb[NEXP])) return false;
        int e = 0, te = 0;
        for (int j = 1; j < NEXP; ++j) { const int tj = __builtin_amdgcn_readfirstlane(tb[j]); if (mt >= tj) { e = j; te = tj; } }
        u.pm = mt; u.pn = ntile; u.pb = e * nN + ntile; u.aux = e * NTOK + (mt - te) * 256;
        return true;
    }
};

__device__ __forceinline__ unsigned cvt_pk_bf16(float lo, float hi) { unsigned r; asm volatile("v_cvt_pk_bf16_f32 %0, %1, %2" : "=v"(r) : "v"(lo), "v"(hi)); return r; }

template <class Epi, class Sched, bool GATHER, bool ALIGN_EPI, bool SP2>
__device__ __forceinline__ void gemm_phase(LAS unsigned char* lds, const Gemm g, const Sched& S, const Epi& E) {
    int tid = threadIdx.x; asm volatile("" : "+v"(tid));
    const int wid = __builtin_amdgcn_readfirstlane(tid >> 6), lane = tid & 63, wr = wid >> 2, wc = wid & 3, fr = lane & 15, fq = lane >> 4;
    int K = g.K; asm volatile("" : "+s"(K)); const int nt = K / BK;
    unsigned voffB[2];
#pragma unroll
    for (int i = 0; i < 2; ++i) { int R, C; stage_rc(tid * 16 + i * 8192, R, C); const int Rb = Epi::PERM ? ((R & ~31) + perm32(R & 31)) : R;
        voffB[i] = (unsigned)(Rb * K + C) * 2u; }
    const size_t kstep = (size_t)(BK * 2);
    const size_t hstep = (size_t)HALF * K * 2;
    const size_t tstep = 2 * hstep;
    const unsigned ldsw = (unsigned)wid * 1024u;
    const int aoff = lds_byte(wr * 64 + fr, fq * 8), boff = lds_byte(wc * 32 + fr, fq * 8);
#define PG8_SA(b, h) (((b) * 2 + (h)) * HTB)
#define PG8_SB(b, h) ((4 + (b) * 2 + (h)) * HTB)
#define PG8_STAGE(bufoff, gbase, voff) do { _Pragma("unroll") for (int _i = 0; _i < 2; ++_i) \
        __builtin_amdgcn_global_load_lds((const unsigned*)((const char*)(gbase) + (voff)[_i]), (LAS unsigned*)(lds + (bufoff) + ldsw + _i * 8192), 16, 0, 0); } while (0)
#define PG8_LDA(dst, b, h) do { _Pragma("unroll") for (int m = 0; m < 4; ++m) _Pragma("unroll") for (int k = 0; k < 2; ++k) dst[m][k] = *(const LAS bf16x8*)(lds + PG8_SA(b, h) + aoff + m * 2048 + k * 1024); } while (0)
#define PG8_LDB(dst, b, h) do { _Pragma("unroll") for (int n = 0; n < 2; ++n) _Pragma("unroll") for (int k = 0; k < 2; ++k) dst[n][k] = *(const LAS bf16x8*)(lds + PG8_SB(b, h) + boff + n * 2048 + k * 1024); } while (0)
#define PG8_MMA(ai, bj, At, Bt) do { __builtin_amdgcn_s_setprio(1); _Pragma("unroll") for (int m = 0; m < 4; ++m) _Pragma("unroll") for (int n = 0; n < 2; ++n) _Pragma("unroll") for (int k = 0; k < 2; ++k) \
        acc[ai][bj][m][n] = __builtin_amdgcn_mfma_f32_16x16x32_bf16(Bt[n][k], At[m][k], acc[ai][bj][m][n], 0, 0, 0); __builtin_amdgcn_s_setprio(0); } while (0)
#define PG8_WAIT_V(n) asm volatile("s_waitcnt vmcnt(" #n ")" ::: "memory")
#define PG8_WAIT_L(n) asm volatile("s_waitcnt lgkmcnt(" #n ")" ::: "memory")
#define PG8_BAR __builtin_amdgcn_s_barrier()
#define PG8_SCHED __builtin_amdgcn_sched_barrier(0)
#define PG8_SETA(V0, V1, u) do { _Pragma("unroll") for (int _i = 0; _i < 2; ++_i) { int r0, r1, Rp_, Cp_; stage_rc(tid * 16 + _i * 8192, Rp_, Cp_); \
        if (GATHER) { r0 = g.rowmap[(u).aux + Rp_]; r1 = g.rowmap[(u).aux + HALF + Rp_]; } else { r0 = (u).pm * BM + Rp_; r1 = r0 + HALF; } \
        V0[_i] = (unsigned)(r0 * K + Cp_) * 2u; V1[_i] = (unsigned)(r1 * K + Cp_) * 2u; } } while (0)
    Unit cur, nxt; int ui = 0;
    if (!S.next(0, cur)) return;
    f32x4 acc[2][2][4][2];
#pragma unroll
    for (int a = 0; a < 2; ++a)
#pragma unroll
        for (int b = 0; b < 2; ++b)
#pragma unroll
            for (int m = 0; m < 4; ++m)
#pragma unroll
                for (int n = 0; n < 2; ++n) acc[a][b][m][n] = (f32x4){0.f, 0.f, 0.f, 0.f};
    bf16x8 At[4][2], B0[2][2], B1[2][2];
    unsigned cA0[2], cA1[2], nA0[2], nA1[2];
    PG8_SETA(cA0, cA1, cur);
    const char* const gA = (const char*)g.A;
    const char* cB = (const char*)g.Bt + (size_t)cur.pb * tstep;
    if constexpr (SP2) {
        PG8_STAGE(PG8_SB(0, 0), cB, voffB); PG8_STAGE(PG8_SB(0, 1), cB + hstep, voffB); PG8_STAGE(PG8_SA(0, 0), gA, cA0); PG8_STAGE(PG8_SA(0, 1), gA, cA1);
        if (wr == 1) PG8_BAR;
        PG8_WAIT_V(2); PG8_BAR;
        PG8_STAGE(PG8_SB(1, 0), cB + kstep, voffB); PG8_STAGE(PG8_SA(1, 0), gA + kstep, cA0); PG8_STAGE(PG8_SB(1, 1), cB + hstep + kstep, voffB);
        PG8_WAIT_V(6); PG8_BAR;
    } else {
        PG8_STAGE(PG8_SB(0, 0), cB, voffB); PG8_STAGE(PG8_SA(0, 0), gA, cA0); PG8_STAGE(PG8_SB(0, 1), cB + hstep, voffB); PG8_STAGE(PG8_SA(0, 1), gA, cA1);
        if (wr == 1) PG8_BAR;
        PG8_WAIT_V(4); PG8_BAR;
        PG8_STAGE(PG8_SB(1, 0), cB + kstep, voffB); PG8_STAGE(PG8_SA(1, 0), gA + kstep, cA0); PG8_STAGE(PG8_SB(1, 1), cB + hstep + kstep, voffB);
        PG8_WAIT_V(6); PG8_BAR;
    }
    for (;;) {
        const bool has_next = S.next(ui + 1, nxt);
        if (has_next) { PG8_SETA(nA0, nA1, nxt); } else {
#pragma unroll
            for (int _i = 0; _i < 2; ++_i) { nA0[_i] = cA0[_i]; nA1[_i] = cA1[_i]; } }
        const char* nB = has_next ? (const char*)g.Bt + (size_t)nxt.pb * tstep : cB;
#pragma unroll 1
        for (int t = 0; t < nt; t += 2) {
            const bool last = (t == nt - 2);
            const char* a1 = gA + (size_t)(t + 1) * kstep;
            const char* a2 = last ? gA : gA + (size_t)(t + 2) * kstep; const char* b2 = last ? nB : cB + (size_t)(t + 2) * kstep;
            const char* a3 = a2 + kstep; const char* b3 = b2 + kstep;
            unsigned xA0[2], xA1[2];
#pragma unroll
            for (int _i = 0; _i < 2; ++_i) { xA0[_i] = last ? nA0[_i] : cA0[_i]; xA1[_i] = last ? nA1[_i] : cA1[_i]; }
            if constexpr (SP2) {
            PG8_LDB(B0, 0, 0); PG8_LDB(B1, 0, 1); PG8_SCHED; PG8_LDA(At, 0, 0); PG8_STAGE(PG8_SA(1, 1), a1, cA1);
            PG8_WAIT_V(8); PG8_WAIT_L(0); PG8_BAR; PG8_MMA(0, 0, At, B0); PG8_MMA(0, 1, At, B1); PG8_BAR; PG8_SCHED;
            PG8_LDA(At, 0, 1); PG8_STAGE(PG8_SB(0, 0), b2, voffB); PG8_STAGE(PG8_SB(0, 1), b2 + hstep, voffB); PG8_STAGE(PG8_SA(0, 0), a2, xA0);
            PG8_WAIT_V(8); PG8_WAIT_L(0); PG8_BAR; PG8_MMA(1, 0, At, B0); PG8_MMA(1, 1, At, B1); PG8_BAR; PG8_SCHED;
            PG8_LDB(B0, 1, 0); PG8_LDB(B1, 1, 1); PG8_SCHED; PG8_LDA(At, 1, 0); PG8_STAGE(PG8_SA(0, 1), a2, xA1);
            PG8_WAIT_V(8); PG8_WAIT_L(0); PG8_BAR; PG8_MMA(0, 0, At, B0); PG8_MMA(0, 1, At, B1); PG8_BAR; PG8_SCHED;
            PG8_LDA(At, 1, 1); PG8_STAGE(PG8_SB(1, 0), b3, voffB); PG8_STAGE(PG8_SB(1, 1), b3 + hstep, voffB); PG8_STAGE(PG8_SA(1, 0), a3, xA0);
            PG8_WAIT_V(8); PG8_WAIT_L(0); PG8_BAR; PG8_MMA(1, 0, At, B0); PG8_MMA(1, 1, At, B1); PG8_BAR; PG8_SCHED;
            } else {
            PG8_LDB(B0, 0, 0); PG8_SCHED; PG8_LDA(At, 0, 0); PG8_STAGE(PG8_SA(1, 1), a1, cA1);
            PG8_WAIT_L(8); PG8_BAR; PG8_WAIT_L(0); PG8_MMA(0, 0, At, B0); PG8_BAR; PG8_SCHED;
            PG8_LDB(B1, 0, 1); PG8_STAGE(PG8_SB(0, 0), b2, voffB);
            PG8_BAR; PG8_WAIT_L(0); PG8_MMA(0, 1, At, B1); PG8_BAR;
            PG8_LDA(At, 0, 1); PG8_STAGE(PG8_SA(0, 0), a2, xA0);
            PG8_BAR; PG8_WAIT_L(0); PG8_MMA(1, 0, At, B0); PG8_BAR; PG8_SCHED;
            PG8_STAGE(PG8_SB(0, 1), b2 + hstep, voffB);
            PG8_WAIT_V(6); PG8_BAR; PG8_MMA(1, 1, At, B1); PG8_BAR;
            PG8_LDB(B0, 1, 0); PG8_SCHED; PG8_LDA(At, 1, 0); PG8_STAGE(PG8_SA(0, 1), a2, xA1);
            PG8_WAIT_L(8); PG8_BAR; PG8_WAIT_L(0); PG8_MMA(0, 0, At, B0); PG8_BAR; PG8_SCHED;
            PG8_LDB(B1, 1, 1); PG8_STAGE(PG8_SB(1, 0), b3, voffB);
            PG8_BAR; PG8_WAIT_L(0); PG8_MMA(0, 1, At, B1); PG8_BAR;
            PG8_LDA(At, 1, 1); PG8_STAGE(PG8_SA(1, 0), a3, xA0);
            PG8_BAR; PG8_WAIT_L(0); PG8_MMA(1, 0, At, B0); PG8_BAR; PG8_SCHED;
            PG8_STAGE(PG8_SB(1, 1), b3 + hstep, voffB);
            PG8_WAIT_V(6); PG8_BAR; PG8_MMA(1, 1, At, B1); PG8_BAR;
            }
        }
        if constexpr (ALIGN_EPI) { if (wr == 0) PG8_BAR; }
        E(acc, cur, wr, wc, fr, fq);
        if (!has_next) break;
#pragma unroll
        for (int a = 0; a < 2; ++a)
#pragma unroll
            for (int b = 0; b < 2; ++b)
#pragma unroll
                for (int m = 0; m < 4; ++m)
#pragma unroll
                    for (int n = 0; n < 2; ++n) acc[a][b][m][n] = (f32x4){0.f, 0.f, 0.f, 0.f};
        cur = nxt; cB = nB; ++ui;
#pragma unroll
        for (int _i = 0; _i < 2; ++_i) { cA0[_i] = nA0[_i]; cA1[_i] = nA1[_i]; }
        if constexpr (ALIGN_EPI) { if (wr == 1) PG8_BAR; }
    }
    PG8_WAIT_V(0);
    if constexpr (!ALIGN_EPI) { if (wr == 0) PG8_BAR; }
    PG8_BAR;
#undef PG8_SA
#undef PG8_SB
#undef PG8_STAGE
#undef PG8_LDA
#undef PG8_LDB
#undef PG8_MMA
#undef PG8_WAIT_V
#undef PG8_WAIT_L
#undef PG8_BAR
#undef PG8_SCHED
#undef PG8_SETA
}

struct EpiProj {
    static constexpr bool PERM = true;
    bf16_t* P; const float* qgain; const float* kgain;
    __device__ __forceinline__ void operator()(const f32x4 (&acc)[2][2][4][2], const Unit& u, int wr, int wc, int fr, int fq) const {
        asm volatile("" : "+v"(fr), "+v"(fq));
        const int row0 = u.pm * BM + wr * 64 + fr; const int pn = u.pn;
        if (pn < 4) {
            const float* gain = (pn < 2) ? qgain : kgain; const float sc = (pn < 2) ? QSCALE : 1.f;
            f32x4 gv[2][2];
#pragma unroll
            for (int bj = 0; bj < 2; ++bj)
#pragma unroll
                for (int n = 0; n < 2; ++n) gv[bj][n] = *(const f32x4*)(gain + 32 * bj + 8 * fq + 4 * n) * sc;
            const int col0 = 256 * pn + 64 * wc + 8 * fq;
#pragma unroll
            for (int ai = 0; ai < 2; ++ai)
#pragma unroll
                for (int m = 0; m < 4; ++m) {
                    float ss = 0.f;
#pragma unroll
                    for (int bj = 0; bj < 2; ++bj)
#pragma unroll
                        for (int n = 0; n < 2; ++n) { const f32x4 x = acc[ai][bj][m][n]; ss += (x[0] * x[0] + x[1] * x[1]) + (x[2] * x[2] + x[3] * x[3]); }
                    ss += __shfl_xor(ss, 16); ss += __shfl_xor(ss, 32);
                    const float rstd = __builtin_amdgcn_rsqf(ss * (1.f / 64.f) + EPS);
                    bf16_t* rowp = P + (size_t)(row0 + ai * HALF + m * 16) * PROJW + col0;
#pragma unroll
                    for (int bj = 0; bj < 2; ++bj) { const f32x4 v0 = acc[ai][bj][m][0] * rstd * gv[bj][0], v1 = acc[ai][bj][m][1] * rstd * gv[bj][1];
                        u32x4 w; w.x = cvt_pk_bf16(v0[0], v0[1]); w.y = cvt_pk_bf16(v0[2], v0[3]); w.z = cvt_pk_bf16(v1[0], v1[1]); w.w = cvt_pk_bf16(v1[2], v1[3]);
                        *(u32x4*)(rowp + bj * 32) = w; }
                }
        } else {
            const float sc = (pn == 6) ? 0.125f : 1.f; const bool act = (pn >= 10);
            const int col0 = 256 * pn + 32 * wc + 8 * fq;
#pragma unroll
            for (int ai = 0; ai < 2; ++ai)
#pragma unroll
                for (int m = 0; m < 4; ++m) { bf16_t* rowp = P + (size_t)(row0 + ai * HALF + m * 16) * PROJW + col0;
#pragma unroll
                    for (int bj = 0; bj < 2; ++bj) { f32x4 v0 = acc[ai][bj][m][0] * sc, v1 = acc[ai][bj][m][1] * sc;
                        if (act) {
#pragma unroll
                            for (int j = 0; j < 4; ++j) { v0[j] = siluf(v0[j]); v1[j] = siluf(v1[j]); } }
                        u32x4 w; w.x = cvt_pk_bf16(v0[0], v0[1]); w.y = cvt_pk_bf16(v0[2], v0[3]); w.z = cvt_pk_bf16(v1[0], v1[1]); w.w = cvt_pk_bf16(v1[2], v1[3]);
                        *(u32x4*)(rowp + bj * HALF) = w; } }
        }
    }
};
struct EpiResid {
    static constexpr bool PERM = true;
    const float* xin; float* X; const float* gate;
    __device__ __forceinline__ void operator()(const f32x4 (&acc)[2][2][4][2], const Unit& u, int wr, int wc, int fr, int fq) const {
        asm volatile("" : "+v"(fr), "+v"(fq));
        const int row0 = u.pm * BM + wr * 64 + fr; const int b = (u.pm * BM) / SEQ;
        const int col0 = u.pn * BM + wc * 32 + 8 * fq; const float* gp = gate + (size_t)b * (NMOD * DM);
#pragma unroll
        for (int ai = 0; ai < 2; ++ai)
#pragma unroll
            for (int m = 0; m < 4; ++m) { const size_t ro = (size_t)(row0 + ai * HALF + m * 16) * DM + col0;
#pragma unroll
                for (int bj = 0; bj < 2; ++bj)
#pragma unroll
                    for (int n = 0; n < 2; ++n) { const f32x4 xi = *(const f32x4*)(xin + ro + bj * HALF + 4 * n); const f32x4 gv = *(const f32x4*)(gp + col0 + bj * HALF + 4 * n);
                        *(f32x4*)(X + ro + bj * HALF + 4 * n) = xi + gv * acc[ai][bj][m][n]; }
                asm volatile("" ::: "memory"); }
    }
};
struct EpiMoeAct {
    static constexpr bool PERM = true;
    bf16_t* ACT; const float* slotw;
    __device__ __forceinline__ void operator()(const f32x4 (&acc)[2][2][4][2], const Unit& u, int wr, int wc, int fr, int fq) const {
        asm volatile("" : "+v"(fr), "+v"(fq));
        const int rl = wr * 64 + fr; const int col0 = 128 * u.pn + 32 * wc + 8 * fq;
#pragma unroll
        for (int ai = 0; ai < 2; ++ai)
#pragma unroll
            for (int m = 0; m < 4; ++m) { const int r = rl + ai * HALF + m * 16; const float w = slotw[u.aux + r];
                f32x4 g0 = acc[ai][0][m][0], g1 = acc[ai][0][m][1]; const f32x4 u0 = acc[ai][1][m][0], u1 = acc[ai][1][m][1];
#pragma unroll
                for (int j = 0; j < 4; ++j) { g0[j] = siluf(g0[j]) * u0[j] * w; g1[j] = siluf(g1[j]) * u1[j] * w; }
                u32x4 o; o.x = cvt_pk_bf16(g0[0], g0[1]); o.y = cvt_pk_bf16(g0[2], g0[3]); o.z = cvt_pk_bf16(g1[0], g1[1]); o.w = cvt_pk_bf16(g1[2], g1[3]);
                *(u32x4*)(ACT + (size_t)(u.pm * BM + r) * DEXP + col0) = o; }
    }
};
struct EpiStore {
    static constexpr bool PERM = true;
    bf16_t* O; int ldc;
    __device__ __forceinline__ void operator()(const f32x4 (&acc)[2][2][4][2], const Unit& u, int wr, int wc, int fr, int fq) const {
        asm volatile("" : "+v"(fr), "+v"(fq));
        const int row0 = u.pm * BM + wr * 64 + fr; const int col0 = u.pn * BM + wc * 32 + 8 * fq;
#pragma unroll
        for (int ai = 0; ai < 2; ++ai)
#pragma unroll
            for (int m = 0; m < 4; ++m) { bf16_t* rowp = O + (size_t)(row0 + ai * HALF + m * 16) * ldc + col0;
#pragma unroll
                for (int bj = 0; bj < 2; ++bj) { const f32x4 v0 = acc[ai][bj][m][0], v1 = acc[ai][bj][m][1];
                    u32x4 w; w.x = cvt_pk_bf16(v0[0], v0[1]); w.y = cvt_pk_bf16(v0[2], v0[3]); w.z = cvt_pk_bf16(v1[0], v1[1]); w.w = cvt_pk_bf16(v1[2], v1[3]);
                    *(u32x4*)(rowp + bj * HALF) = w; } }
    }
};
}

#define XB_TMO      128
#define XB_XCNT(j)  (256  + 64 * (j))
#define XB_XSUB(j)  (1280 + 64 * (j))
#define XB_XGEN(j)  (2304 + 64 * (j))
#define XB_TOP      3328
#define XB_TOPGEN   3392
#define XCD_BAR_WORDS 3456
#define XB_SPIN_CAP (1u << 18)
__device__ __forceinline__ unsigned xb_ld(unsigned* p)              { return __hip_atomic_load(p, __ATOMIC_RELAXED, __HIP_MEMORY_SCOPE_AGENT); }
__device__ __forceinline__ unsigned xb_add(unsigned* p, unsigned v) { return __hip_atomic_fetch_add(p, v, __ATOMIC_RELAXED, __HIP_MEMORY_SCOPE_AGENT); }
__device__ __forceinline__ unsigned xb_xcc_id() { return (unsigned)__builtin_amdgcn_s_getreg((3 << 11) | 20) & 0xFu; }
#define XB_SPIN(cond, bar) do { unsigned _sp = 0; while (cond) { __builtin_amdgcn_s_sleep(1); \
    if ((++_sp & 255u) == 0u) { if (xb_ld(&(bar)[XB_TMO])) break; if (_sp > XB_SPIN_CAP) { atomicAdd(&(bar)[XB_TMO], 1u); break; } } } } while (0)
struct XcdBarrier { unsigned* bar; unsigned x; volatile LAS unsigned* st; };
__device__ __forceinline__ XcdBarrier xcd_barrier_post(unsigned* bar, volatile LAS unsigned* st) {
    XcdBarrier b; b.bar = bar; b.x = xb_xcc_id(); b.st = st;
    if (threadIdx.x == 0) (void)xb_add(&bar[XB_XCNT(b.x)], 1u);
    return b;
}
__device__ __forceinline__ void xcd_barrier_complete(unsigned* bar, unsigned x, unsigned& nloc, unsigned& nx) {
    const unsigned G = gridDim.x * gridDim.y * gridDim.z;
    unsigned sum, cnt, mine, sp = 0u;
    for (;;) {
        sum = 0u; cnt = 0u; mine = 0u;
#pragma unroll
        for (unsigned j = 0; j < 16; ++j) { const unsigned c = xb_ld(&bar[XB_XCNT(j)]); sum += c; cnt += (c > 0u) ? 1u : 0u; mine = (j == x) ? c : mine; }
        if (sum == G) break;
        __builtin_amdgcn_s_sleep(1);
        if ((++sp & 255u) == 0u) { if (xb_ld(&bar[XB_TMO])) break; if (sp > XB_SPIN_CAP) { atomicAdd(&bar[XB_TMO], 1u); break; } }
    }
    nloc = mine > 0u ? mine : 1u; nx = cnt > 0u ? cnt : 1u;
}
__device__ __forceinline__ void xcd_barrier(const XcdBarrier& b) {
    asm volatile("s_waitcnt vmcnt(0)" ::: "memory");
    __syncthreads();
    if (threadIdx.x == 0) {
        unsigned* bar = b.bar;
        __builtin_amdgcn_s_waitcnt(0);
        unsigned nloc = b.st[0], nx = b.st[1];
        if (nloc == 0u) { xcd_barrier_complete(bar, b.x, nloc, nx); b.st[0] = nloc; b.st[1] = nx; }
        const unsigned old = xb_add(&bar[XB_XSUB(b.x)], 1u);
        const unsigned gen = old / nloc;
        if (old + 1u == (gen + 1u) * nloc) {
            __builtin_amdgcn_fence(__ATOMIC_RELEASE, "agent");
            asm volatile("s_waitcnt vmcnt(0)" ::: "memory");
            const unsigned og = xb_add(&bar[XB_TOP], 1u);
            const unsigned tg = og / nx;
            if (og + 1u == (tg + 1u) * nx) xb_add(&bar[XB_TOPGEN], 1u);
            else XB_SPIN(xb_ld(&bar[XB_TOPGEN]) == tg, bar);
            __builtin_amdgcn_fence(__ATOMIC_ACQUIRE, "agent");
            xb_add(&bar[XB_XGEN(b.x)], 1u);
            asm volatile("s_waitcnt vmcnt(0)" ::: "memory");
        } else {
            XB_SPIN(xb_ld(&bar[XB_XGEN(b.x)]) == gen, bar);
            __builtin_amdgcn_fence(__ATOMIC_ACQUIRE, "agent");
            asm volatile("s_waitcnt vmcnt(0)" ::: "memory");
        }
    }
    __syncthreads();
}

constexpr int NWAVES = 8, NTHR = 512;
struct Frame {
    LAS unsigned char* lds;
    volatile LAS unsigned* MISC;
    unsigned* ctl;
    int tid, lane, wave, vcu, G;
    float* out; unsigned char* ws;
};
constexpr int PTAB_OFF = LDSCTL_OFF + 512;
__device__ __forceinline__ const float* inptr(const Frame& F, int i) {
    const LAS unsigned* p = (const LAS unsigned*)(F.lds + PTAB_OFF) + 2 * i;
    const unsigned lo = __builtin_amdgcn_readfirstlane(p[0]), hi = __builtin_amdgcn_readfirstlane(p[1]);
    return (const float*)(((unsigned long long)hi << 32) | lo);
}
#define F_X (inptr(F, 0))
#define F_C (inptr(F, 1))
#define F_WADA (inptr(F, 2))
#define F_BADA (inptr(F, 3))
#define F_NMIX (inptr(F, 4))
#define F_NFFN (inptr(F, 5))
#define F_WIN (inptr(F, 6))
#define F_WGK2 (inptr(F, 7))
#define F_BGK (inptr(F, 8))
#define F_QGAIN (inptr(F, 9))
#define F_KGAIN (inptr(F, 10))
#define F_GLAGAIN (inptr(F, 11))
#define F_WOUT (inptr(F, 12))
#define F_WRG (inptr(F, 13))
#define F_BRG (inptr(F, 14))
#define F_WRE (inptr(F, 15))
#define F_BRE (inptr(F, 16))
#define F_WGATE (inptr(F, 17))
#define F_WUP (inptr(F, 18))
#define F_WDOWN (inptr(F, 19))

#define PHASE_FRAME(F0) Frame F; { unsigned char* ws_ = (F0).ws; float* out_ = (F0).out; int tid_ = threadIdx.x, g_ = (F0).G, vcu_ = (F0).vcu; \
    asm volatile("" : "+s"(ws_), "+s"(out_), "+v"(tid_), "+s"(g_), "+s"(vcu_)); \
    F.lds = (F0).lds; F.MISC = (F0).MISC; F.ws = ws_; F.out = out_; F.ctl = (unsigned*)ws_; F.tid = tid_; F.lane = tid_ & 63; F.wave = __builtin_amdgcn_readfirstlane(tid_ >> 6); F.G = g_; F.vcu = vcu_; }

__device__ __forceinline__ void p0_transpose_item(const float* W, int K, int N, bf16* WT, int k0, int n0, int drow0, LAS float* scr, int lane) {
#pragma unroll 8
    for (int i = 0; i < 32; ++i) { const int kk = 2 * i + (lane >> 5); scr[kk * 33 + (lane & 31)] = W[(size_t)(k0 + kk) * N + n0 + (lane & 31)]; }
    LDS_WAIT(); asm volatile("" ::: "memory");
    const int c = lane & 7;
#pragma unroll
    for (int j = 0; j < 4; ++j) { const int n = (lane >> 3) + 8 * j; const LAS float* s = scr + (8 * c) * 33 + n;
        u32x4 o; o.x = pk2(s[0 * 33], s[1 * 33]); o.y = pk2(s[2 * 33], s[3 * 33]); o.z = pk2(s[4 * 33], s[5 * 33]); o.w = pk2(s[6 * 33], s[7 * 33]);
        *(u32x4*)(WT + (size_t)(drow0 + n) * K + k0 + 8 * c) = o; }
    LDS_WAIT(); asm volatile("" ::: "memory");
}
__device__ __forceinline__ void p0_prologue(Frame& F0) {
    PHASE_FRAME(F0);
    LAS float* scr = (LAS float*)(F.lds + F.wave * 16384);
    const int gw = F.vcu * NWAVES + F.wave, NGW = F.G * NWAVES, lane = F.lane;
    constexpr int I_IN = 16 * 96, I_OUT = 16 * 32, I_G = NEXP * 16 * 8, I_D = NEXP * 4 * 32, I_LAYER = I_IN + I_OUT + 2 * I_G + I_D;
    for (int it = gw; it < NL * I_LAYER; it += NGW) {
        const int l = it / I_LAYER; int r = it - l * I_LAYER;
        if (r < I_IN) {
            const int kb = r / 96, nb = r % 96, n0 = nb * 32; int drow0 = n0;
            if (n0 < 1024) { const int sec = n0 >> 9, f = n0 & 511, head = f >> 6, bjp = (f >> 5) & 1; drow0 = sec * 512 + 256 * (head >> 2) + 128 * bjp + 32 * (head & 3); }
            p0_transpose_item(F_WIN + (size_t)l * DM * DIN, DM, DIN, (bf16*)(F.ws + WS_WIN) + (size_t)l * PROJW * DM, kb * 64, n0, drow0, scr, lane); continue; }
        r -= I_IN;
        if (r < I_OUT) { const int kb = r / 32, nb = r % 32;
            p0_transpose_item(F_WOUT + (size_t)l * DM * DM, DM, DM, (bf16*)(F.ws + WS_WOUT) + (size_t)l * DM * DM, kb * 64, nb * 32, nb * 32, scr, lane); continue; }
        r -= I_OUT;
        if (r < 2 * I_G) { const int up = r / I_G; r -= up * I_G; const int e = r / 128, q = r % 128, kb = q / 8, nb = q % 8, n0 = nb * 32;
            const float* W = (up ? F_WUP : F_WGATE) + ((size_t)l * NEXP + e) * DM * DEXP;
            bf16* WT = (bf16*)(F.ws + WS_W1) + ((size_t)l * NEXP + e) * 512 * DM;
            p0_transpose_item(W, DM, DEXP, WT, kb * 64, n0, 256 * (n0 >> 7) + 128 * up + (n0 & 127), scr, lane); continue; }
        r -= 2 * I_G;
        { const int e = r / 128, q = r % 128, kb = q / 32, nb = q % 32;
            p0_transpose_item(F_WDOWN + ((size_t)l * NEXP + e) * DEXP * DM, DEXP, DM, (bf16*)(F.ws + WS_W2) + ((size_t)l * NEXP + e) * DM * DEXP, kb * 64, nb * 32, nb * 32, scr, lane); }
    }
    for (int idx = F.vcu * NTHR + F.tid; idx < NL * 64 * DM; idx += F.G * NTHR) {
        const int k = idx & (DM - 1), n = (idx >> 10) & 63, l = idx >> 16; float v = 0.f;
        if (n < 16) v = F_WIN[((size_t)l * DM + k) * DIN + PROJW + n];
        else if (n < 20) v = F_WRG[((size_t)l * DM + k) * NGRP + (n - 16)];
        else if (n < 52) v = F_WRE[((size_t)l * DM + k) * NEXP + (n - 20)];
        ((_Float16*)(F.ws + WS_WSM))[idx] = (_Float16)v;
    }
    float* mod = (float*)(F.ws + WS_MOD);
    for (int idx = F.vcu * NTHR + F.tid; idx < NL * NMOD * DM; idx += F.G * NTHR) {
        const int l = idx / (NMOD * DM), j = idx - l * (NMOD * DM);
        float a[NB];
#pragma unroll
        for (int b = 0; b < NB; ++b) a[b] = 0.f;
        const float* w = F_WADA + (size_t)l * DM * NMOD * DM + j;
        for (int k = 0; k < DM; ++k) { const float wv = w[(size_t)k * NMOD * DM];
#pragma unroll
            for (int b = 0; b < NB; ++b) a[b] += siluf(F_C[b * DM + k]) * wv; }
        const float bias = F_BADA[idx];
#pragma unroll
        for (int b = 0; b < NB; ++b) mod[((size_t)l * NB + b) * NMOD * DM + j] = a[b] + bias;
    }
}

__device__ __forceinline__ void tile_bases(Frame& F, int l) {
    LAS int* tb = (LAS int*)(F.lds + LDSCTL_OFF);
    __syncthreads();
    if (F.tid == 0) { int s = 0; for (int e = 0; e < NEXP; ++e) { tb[e] = s; s += ((int)F.ctl[CW_CNT + l * 64 + e] + 255) >> 8; } tb[NEXP] = s; }
    __syncthreads();
}

__device__ __forceinline__ void phase_norm_a(Frame& F0, int l) {
    PHASE_FRAME(F0);
    const int gw = F.vcu * NWAVES + F.wave, NGW = F.G * NWAVES, lane = F.lane;
    const float* mod = (const float*)(F.ws + WS_MOD);
    if (l > 0) tile_bases(F, l - 1);
    const LAS int* tb = (const LAS int*)(F.lds + LDSCTL_OFF);
    const int* toke = (const int*)(F.ws + WS_TOKE); const int* tokp = (const int*)(F.ws + WS_TOKP);
    const bf16* Y = (const bf16*)(F.ws + WS_Y);
    bf16* H = (bf16*)(F.ws + WS_H); float* GLR = (float*)(F.ws + WS_GLR);
    for (int t = gw; t < NTOK; t += NGW) {
        const int b = t / SEQ;
        f32x4 v[4];
        const float* xr = (l == 0 ? F_X : F.out) + (size_t)t * DM;
#pragma unroll
        for (int j = 0; j < 4; ++j) v[j] = *(const f32x4*)(xr + 4 * lane + 256 * j);
        if (l > 0) {
            const float* gf = mod + ((size_t)(l - 1) * NB + b) * NMOD * DM + 5 * DM;
            const int e0 = toke[2 * t], e1 = toke[2 * t + 1];
            const size_t s0 = (size_t)tb[e0] * 256 + tokp[2 * t], s1 = (size_t)tb[e1] * 256 + tokp[2 * t + 1];
#pragma unroll
            for (int j = 0; j < 4; ++j) { const int c = 4 * lane + 256 * j;
                const u32x2 y0 = *(const u32x2*)(Y + s0 * DM + c), y1 = *(const u32x2*)(Y + s1 * DM + c); const f32x4 g = *(const f32x4*)(gf + c);
                v[j][0] += g[0] * (bflo(y0.x) + bflo(y1.x)); v[j][1] += g[1] * (bfhi(y0.x) + bfhi(y1.x));
                v[j][2] += g[2] * (bflo(y0.y) + bflo(y1.y)); v[j][3] += g[3] * (bfhi(y0.y) + bfhi(y1.y));
                *(f32x4*)(F.out + (size_t)t * DM + c) = v[j]; }
        }
        if (l == NL) continue;
        float ss = 0.f;
#pragma unroll
        for (int j = 0; j < 4; ++j) ss += (v[j][0] * v[j][0] + v[j][1] * v[j][1]) + (v[j][2] * v[j][2] + v[j][3] * v[j][3]);
        const float rstd = 1.f / sqrtf(wave_sum(ss) * (1.f / DM) + EPS);
        const float* mrow = mod + ((size_t)l * NB + b) * NMOD * DM;
        float glr[GRANK];
#pragma unroll
        for (int r = 0; r < GRANK; ++r) glr[r] = 0.f;
#pragma unroll
        for (int j = 0; j < 4; ++j) { const int c = 4 * lane + 256 * j;
            const f32x4 gn = *(const f32x4*)(F_NMIX + l * DM + c), sh = *(const f32x4*)(mrow + c), sc = *(const f32x4*)(mrow + DM + c);
            f32x4 h;
#pragma unroll
            for (int i = 0; i < 4; ++i) h[i] = v[j][i] * rstd * gn[i] * (1.f + sc[i]) + sh[i];
            u32x2 o; o.x = pk2(h[0], h[1]); o.y = pk2(h[2], h[3]);
            *(u32x2*)(H + (size_t)t * DM + c) = o;
#pragma unroll
            for (int i = 0; i < 4; ++i) { const float* wl = F_WIN + ((size_t)l * DM + c + i) * DIN + PROJW;
#pragma unroll
                for (int r4 = 0; r4 < 4; ++r4) { const f32x4 w = *(const f32x4*)(wl + 4 * r4);
                    glr[4 * r4] += h[i] * w[0]; glr[4 * r4 + 1] += h[i] * w[1]; glr[4 * r4 + 2] += h[i] * w[2]; glr[4 * r4 + 3] += h[i] * w[3]; } }
        }
#pragma unroll
        for (int r = 0; r < GRANK; ++r) glr[r] = wave_sum(glr[r]);
        if (lane == 0) {
#pragma unroll
            for (int r4 = 0; r4 < 4; ++r4) *(f32x4*)(GLR + (size_t)t * GRANK + 4 * r4) = (f32x4){glr[4 * r4], glr[4 * r4 + 1], glr[4 * r4 + 2], glr[4 * r4 + 3]};
        }
    }
}

__device__ __forceinline__ void phase_norm_e(Frame& F0, int l) {
    PHASE_FRAME(F0);
    const int gw = F.vcu * NWAVES + F.wave, NGW = F.G * NWAVES, lane = F.lane;
    const float* mod = (const float*)(F.ws + WS_MOD);
    int* toke = (int*)(F.ws + WS_TOKE); int* tokp = (int*)(F.ws + WS_TOKP);
    int* tokof = (int*)(F.ws + WS_TOKOF); float* slotw = (float*)(F.ws + WS_SLOTW);
    bf16* H = (bf16*)(F.ws + WS_H);
    unsigned* cnt = F.ctl + CW_CNT + l * 64;
    for (int t = gw; t < NTOK; t += NGW) {
        const int b = t / SEQ;
        f32x4 v[4];
        const float* xr = F.out + (size_t)t * DM;
#pragma unroll
        for (int j = 0; j < 4; ++j) v[j] = *(const f32x4*)(xr + 4 * lane + 256 * j);
        float ss = 0.f;
#pragma unroll
        for (int j = 0; j < 4; ++j) ss += (v[j][0] * v[j][0] + v[j][1] * v[j][1]) + (v[j][2] * v[j][2] + v[j][3] * v[j][3]);
        const float rstd = 1.f / sqrtf(wave_sum(ss) * (1.f / DM) + EPS);
        const float* mrow = mod + ((size_t)l * NB + b) * NMOD * DM;
        float lg[36];
#pragma unroll
        for (int r = 0; r < 36; ++r) lg[r] = 0.f;
#pragma unroll
        for (int j = 0; j < 4; ++j) { const int c = 4 * lane + 256 * j;
            const f32x4 gn = *(const f32x4*)(F_NFFN + l * DM + c), sh = *(const f32x4*)(mrow + 3 * DM + c), sc = *(const f32x4*)(mrow + 4 * DM + c);
            f32x4 h;
#pragma unroll
            for (int i = 0; i < 4; ++i) h[i] = v[j][i] * rstd * gn[i] * (1.f + sc[i]) + sh[i];
            u32x2 o; o.x = pk2(h[0], h[1]); o.y = pk2(h[2], h[3]);
            *(u32x2*)(H + (size_t)t * DM + c) = o;
#pragma unroll
            for (int i = 0; i < 4; ++i) {
                const f32x4 wg = *(const f32x4*)(F_WRG + ((size_t)l * DM + c + i) * NGRP);
                lg[0] += h[i] * wg[0]; lg[1] += h[i] * wg[1]; lg[2] += h[i] * wg[2]; lg[3] += h[i] * wg[3];
                const float* we = F_WRE + ((size_t)l * DM + c + i) * NEXP;
#pragma unroll
                for (int r4 = 0; r4 < 8; ++r4) { const f32x4 w = *(const f32x4*)(we + 4 * r4);
                    lg[4 + 4 * r4] += h[i] * w[0]; lg[5 + 4 * r4] += h[i] * w[1]; lg[6 + 4 * r4] += h[i] * w[2]; lg[7 + 4 * r4] += h[i] * w[3]; } }
        }
#pragma unroll
        for (int r = 0; r < 36; ++r) lg[r] = wave_sum(lg[r]);
        if (lane == 0) {
            float gl[4]; int gi = 0;
#pragma unroll
            for (int g = 0; g < 4; ++g) gl[g] = lg[g] + F_BRG[l * NGRP + g];
            float gmax = gl[0];
#pragma unroll
            for (int g = 1; g < 4; ++g) if (gl[g] > gmax) { gmax = gl[g]; gi = g; }
            float den = 0.f;
#pragma unroll
            for (int g = 0; g < 4; ++g) den += __expf(gl[g] - gmax);
            const float gw_ = 1.f / den;
            float el[8];
#pragma unroll
            for (int e = 0; e < 8; ++e) el[e] = 0.f;
#pragma unroll
            for (int g = 0; g < 4; ++g) if (g == gi) {
#pragma unroll
                for (int e = 0; e < 8; ++e) el[e] = lg[4 + 8 * g + e] + F_BRE[l * NEXP + 8 * g + e]; }
            int i0 = 0; float l0 = el[0];
#pragma unroll
            for (int e = 1; e < 8; ++e) if (el[e] > l0) { l0 = el[e]; i0 = e; }
            int i1 = -1; float l1 = -3.0e38f;
#pragma unroll
            for (int e = 0; e < 8; ++e) if (e != i0 && el[e] > l1) { l1 = el[e]; i1 = e; }
            const float ex = __expf(l1 - l0); const float w0 = gw_ / (1.f + ex), w1 = gw_ * ex / (1.f + ex);
            const int e0 = gi * 8 + i0, e1 = gi * 8 + i1;
            const int p0 = (int)atomicAdd(&cnt[e0], 1u), p1 = (int)atomicAdd(&cnt[e1], 1u);
            toke[2 * t] = e0; toke[2 * t + 1] = e1; tokp[2 * t] = p0; tokp[2 * t + 1] = p1;
            tokof[(size_t)e0 * NTOK + p0] = t; tokof[(size_t)e1 * NTOK + p1] = t;
            slotw[(size_t)e0 * NTOK + p0] = w0; slotw[(size_t)e1 * NTOK + p1] = w1;
        }
    }
}

namespace nrm {
typedef _Float16 f16x8 __attribute__((ext_vector_type(8)));
typedef _Float16 f16x4 __attribute__((ext_vector_type(4)));
constexpr int TROW = 2064, L_PART = 32 * TROW, L_LOG = L_PART + 8 * 32 * 48 * 4, L_REC = L_LOG + 32 * 48 * 4, L_LC = L_REC + 8 * 32 * 32, L_GB = L_LC + 128;
static_assert(L_GB + 128 <= LDSCTL_OFF, "norm phase LDS map");
}
template <int MODE>
__device__ __forceinline__ void phase_norm_fast(Frame& F0, int l) {
    using namespace nrm;
    PHASE_FRAME(F0);
    constexpr int NBLK = MODE ? 3 : 1, NC = 16 * NBLK;
    const int lane = F.lane, w = F.wave, tid = F.tid, fr = lane & 15, fq = lane >> 4;
    const float* mod = (const float*)(F.ws + WS_MOD);
    const _Float16* wsm = (const _Float16*)(F.ws + WS_WSM) + ((size_t)l * 64 + (MODE ? 16 : 0)) * DM;
    bf16* H = (bf16*)(F.ws + WS_H);
    LAS unsigned char* lds = F.lds;
    f16x8 bfr[4][NBLK];
#pragma unroll
    for (int ks = 0; ks < 4; ++ks)
#pragma unroll
        for (int nb = 0; nb < NBLK; ++nb) bfr[ks][nb] = *(const f16x8*)(wsm + (size_t)(16 * nb + fr) * DM + 128 * w + 32 * ks + 8 * fq);
    if (MODE == 0 && l > 0) tile_bases(F, l - 1);
    const LAS int* tb = (const LAS int*)(lds + LDSCTL_OFF);
    if (MODE == 1) { if (tid < 32) ((LAS unsigned*)(lds + L_LC))[tid] = 0u; }
    __syncthreads();
    const float* nrmw = (MODE ? F_NFFN : F_NMIX) + l * DM;
    const float* xin = (MODE == 0 && l == 0) ? F_X : F.out;
    int tl = 0;
    for (int tile = F.vcu; tile < NTOK / 32; tile += F.G, ++tl) {
        const int b = (tile * 32) / SEQ;
        const float* mrow = mod + ((size_t)l * NB + b) * NMOD * DM + (MODE ? 3 * DM : 0);
#pragma unroll 1
        for (int rr = 0; rr < 4; ++rr) {
            const int trow = 4 * w + rr; const size_t t = (size_t)tile * 32 + trow;
            f32x4 v[4];
#pragma unroll
            for (int j = 0; j < 4; ++j) v[j] = *(const f32x4*)(xin + t * DM + 4 * lane + 256 * j);
            if (MODE == 0 && l > 0) {
                const int* toke = (const int*)(F.ws + WS_TOKE); const int* tokp = (const int*)(F.ws + WS_TOKP); const bf16* Y = (const bf16*)(F.ws + WS_Y);
                const float* gf = mod + ((size_t)(l - 1) * NB + b) * NMOD * DM + 5 * DM;
                const int e0 = toke[2 * t], e1 = toke[2 * t + 1];
                const size_t s0 = (size_t)tb[e0] * 256 + tokp[2 * t], s1 = (size_t)tb[e1] * 256 + tokp[2 * t + 1];
#pragma unroll
                for (int j = 0; j < 4; ++j) { const int c = 4 * lane + 256 * j;
                    const u32x2 y0 = *(const u32x2*)(Y + s0 * DM + c), y1 = *(const u32x2*)(Y + s1 * DM + c); const f32x4 g = *(const f32x4*)(gf + c);
                    v[j][0] += g[0] * (bflo(y0.x) + bflo(y1.x)); v[j][1] += g[1] * (bfhi(y0.x) + bfhi(y1.x));
                    v[j][2] += g[2] * (bflo(y0.y) + bflo(y1.y)); v[j][3] += g[3] * (bfhi(y0.y) + bfhi(y1.y));
                    *(f32x4*)(F.out + t * DM + c) = v[j]; }
            }
            float ss = 0.f;
#pragma unroll
            for (int j = 0; j < 4; ++j) ss += (v[j][0] * v[j][0] + v[j][1] * v[j][1]) + (v[j][2] * v[j][2] + v[j][3] * v[j][3]);
            const float rstd = 1.f / sqrtf(wave_sum(ss) * (1.f / DM) + EPS);
#pragma unroll
            for (int j = 0; j < 4; ++j) { const int c = 4 * lane + 256 * j;
                const f32x4 gn = *(const f32x4*)(nrmw + c), sh = *(const f32x4*)(mrow + c), sc = *(const f32x4*)(mrow + DM + c);
                f32x4 hv;
#pragma unroll
                for (int i = 0; i < 4; ++i) hv[i] = v[j][i] * rstd * gn[i] * (1.f + sc[i]) + sh[i];
                u32x2 o; o.x = pk2(hv[0], hv[1]); o.y = pk2(hv[2], hv[3]);
                *(u32x2*)(H + t * DM + c) = o;
                *(LAS f16x4*)(lds + trow * TROW + c * 2) = (f16x4){(_Float16)hv[0], (_Float16)hv[1], (_Float16)hv[2], (_Float16)hv[3]}; }
        }
        __syncthreads();
        {
            f32x4 acc[2][NBLK];
#pragma unroll
            for (int mb = 0; mb < 2; ++mb)
#pragma unroll
                for (int nb = 0; nb < NBLK; ++nb) acc[mb][nb] = (f32x4){0.f, 0.f, 0.f, 0.f};
#pragma unroll
            for (int ks = 0; ks < 4; ++ks)
#pragma unroll
                for (int mb = 0; mb < 2; ++mb) { const f16x8 a = *(const LAS f16x8*)(lds + (16 * mb + fr) * TROW + (128 * w + 32 * ks + 8 * fq) * 2);
#pragma unroll
                    for (int nb = 0; nb < NBLK; ++nb) acc[mb][nb] = __builtin_amdgcn_mfma_f32_16x16x32_f16(a, bfr[ks][nb], acc[mb][nb], 0, 0, 0); }
            LAS float* part = (LAS float*)(lds + L_PART) + w * 32 * 48;
#pragma unroll
            for (int mb = 0; mb < 2; ++mb)
#pragma unroll
                for (int nb = 0; nb < NBLK; ++nb)
#pragma unroll
                    for (int i = 0; i < 4; ++i) part[(16 * mb + 4 * fq + i) * 48 + 16 * nb + fr] = acc[mb][nb][i];
        }
        __syncthreads();
        for (int o = tid; o < 32 * NC; o += NTHR) { const int row = o / NC, col = o - row * NC; float a = 0.f;
#pragma unroll
            for (int ww = 0; ww < 8; ++ww) a += ((const LAS float*)(lds + L_PART))[ww * 32 * 48 + row * 48 + col];
            if (MODE == 0) ((float*)(F.ws + WS_GLR))[((size_t)tile * 32 + row) * GRANK + col] = a;
            else ((LAS float*)(lds + L_LOG))[row * 48 + col] = a; }
        if (MODE == 1) {
            __syncthreads();
            if (tid < 32) {
                const LAS float* lg = (const LAS float*)(lds + L_LOG) + tid * 48;
                float gl[4]; int gi = 0;
#pragma unroll
                for (int g = 0; g < 4; ++g) gl[g] = lg[g] + F_BRG[l * NGRP + g];
                float gmax = gl[0];
#pragma unroll
                for (int g = 1; g < 4; ++g) if (gl[g] > gmax) { gmax = gl[g]; gi = g; }
                float den = 0.f;
#pragma unroll
                for (int g = 0; g < 4; ++g) den += __expf(gl[g] - gmax);
                const float gw_ = 1.f / den;
                float el[8];
#pragma unroll
                for (int e = 0; e < 8; ++e) el[e] = lg[4 + 8 * gi + e] + F_BRE[l * NEXP + 8 * gi + e];
                int i0 = 0; float l0 = el[0];
#pragma unroll
                for (int e = 1; e < 8; ++e) if (el[e] > l0) { l0 = el[e]; i0 = e; }
                int i1 = -1; float l1 = -3.0e38f;
#pragma unroll
                for (int e = 0; e < 8; ++e) if (e != i0 && el[e] > l1) { l1 = el[e]; i1 = e; }
                const float ex = __expf(l1 - l0); const float w0 = gw_ / (1.f + ex), w1 = gw_ * ex / (1.f + ex);
                const int e0 = gi * 8 + i0, e1 = gi * 8 + i1;
                LAS unsigned* lc = (LAS unsigned*)(lds + L_LC);
                const unsigned r0 = __hip_atomic_fetch_add(&lc[e0], 1u, __ATOMIC_RELAXED, __HIP_MEMORY_SCOPE_WORKGROUP), r1 = __hip_atomic_fetch_add(&lc[e1], 1u, __ATOMIC_RELAXED, __HIP_MEMORY_SCOPE_WORKGROUP);
                LAS unsigned* rec = (LAS unsigned*)(lds + L_REC) + (tl * 32 + tid) * 8;
                rec[0] = (unsigned)e0; rec[1] = (unsigned)e1; rec[2] = r0; rec[3] = r1; rec[4] = __builtin_bit_cast(unsigned, w0); rec[5] = __builtin_bit_cast(unsigned, w1);
            }
        }
    }
    if (MODE == 1) {
        __syncthreads();
        unsigned* cnt = F.ctl + CW_CNT + l * 64;
        if (tid < 32) { const unsigned c = ((LAS unsigned*)(lds + L_LC))[tid]; ((LAS unsigned*)(lds + L_GB))[tid] = c ? atomicAdd(&cnt[tid], c) : 0u; }
        __syncthreads();
        int* toke = (int*)(F.ws + WS_TOKE); int* tokp = (int*)(F.ws + WS_TOKP); int* tokof = (int*)(F.ws + WS_TOKOF); float* slotw = (float*)(F.ws + WS_SLOTW);
        for (int i = tid; i < tl * 32; i += NTHR) {
            const LAS unsigned* rec = (const LAS unsigned*)(lds + L_REC) + i * 8; const LAS unsigned* gb = (const LAS unsigned*)(lds + L_GB);
            const int tile = F.vcu + (i >> 5) * F.G; const int t = tile * 32 + (i & 31);
            const int e0 = (int)rec[0], e1 = (int)rec[1]; const int p0 = (int)(gb[e0] + rec[2]), p1 = (int)(gb[e1] + rec[3]);
            toke[2 * t] = e0; toke[2 * t + 1] = e1; tokp[2 * t] = p0; tokp[2 * t + 1] = p1;
            tokof[(size_t)e0 * NTOK + p0] = t; tokof[(size_t)e1 * NTOK + p1] = t;
            slotw[(size_t)e0 * NTOK + p0] = __builtin_bit_cast(float, rec[4]); slotw[(size_t)e1 * NTOK + p1] = __builtin_bit_cast(float, rec[5]);
        }
    }
    __syncthreads();
}

__device__ __forceinline__ void phase_pad_lists(Frame& F0, int l) {
    PHASE_FRAME(F0);
    int* tokof = (int*)(F.ws + WS_TOKOF); float* slotw = (float*)(F.ws + WS_SLOTW);
    for (int e = F.vcu; e < NEXP; e += F.G) { const int c = (int)F.ctl[CW_CNT + l * 64 + e]; const int cp = (c + 255) & ~255;
        for (int i = c + F.tid; i < cp; i += NTHR) { tokof[(size_t)e * NTOK + i] = 0; slotw[(size_t)e * NTOK + i] = 0.f; } }
}

__device__ __forceinline__ void phase_logdecay(Frame& F0, int l) {
    PHASE_FRAME(F0);
    const float* GLR = (const float*)(F.ws + WS_GLR); float* LG = (float*)(F.ws + WS_LG);
    for (int idx = F.vcu * NTHR + F.tid; idx < NTOK * GKW; idx += F.G * NTHR) {
        const int t = idx >> 8, c = idx & 255;
        float p = F_BGK[l * GKW + c];
#pragma unroll
        for (int r = 0; r < GRANK; ++r) p += GLR[(size_t)t * GRANK + r] * F_WGK2[((size_t)l * GRANK + r) * GKW + c];
        const float sp = fmaxf(-p, 0.f) + log1pf(__expf(-fabsf(p)));
        LG[idx] = -sp * (1.f / 16.f);
    }
}
__device__ __forceinline__ void phase_sb_naive(Frame& F0) {
    PHASE_FRAME(F0);
    const bf16* P = (const bf16*)(F.ws + WS_PROJ); bf16* MIX = (bf16*)(F.ws + WS_MIX);
    for (int idx = F.vcu * NTHR + F.tid; idx < NB * SBH * SEQ; idx += F.G * NTHR) {
        const int q = idx & (SEQ - 1), h = (idx >> 12) & 7, b = idx >> 15;
        const size_t trow = (size_t)b * SEQ + q;
        float qv[64], o[64];
#pragma unroll
        for (int c = 0; c < 8; ++c) { const u32x4 w = *(const u32x4*)(P + trow * PROJW + PC_Q + h * 64 + 8 * c);
            qv[8 * c] = bflo(w.x); qv[8 * c + 1] = bfhi(w.x); qv[8 * c + 2] = bflo(w.y); qv[8 * c + 3] = bfhi(w.y); qv[8 * c + 4] = bflo(w.z); qv[8 * c + 5] = bfhi(w.z); qv[8 * c + 6] = bflo(w.w); qv[8 * c + 7] = bfhi(w.w); }
#pragma unroll
        for (int d = 0; d < 64; ++d) o[d] = 0.f;
        float accl = 0.f;
        for (int s = q - 1; s >= 0; --s) {
            const bf16* kr = P + ((size_t)b * SEQ + s) * PROJW + PC_K + h * 64;
            float z = 0.f;
#pragma unroll
            for (int c = 0; c < 8; ++c) { const u32x4 w = *(const u32x4*)(kr + 8 * c);
                z += qv[8 * c] * bflo(w.x) + qv[8 * c + 1] * bfhi(w.x) + qv[8 * c + 2] * bflo(w.y) + qv[8 * c + 3] * bfhi(w.y) + qv[8 * c + 4] * bflo(w.z) + qv[8 * c + 5] * bfhi(w.z) + qv[8 * c + 6] * bflo(w.w) + qv[8 * c + 7] * bfhi(w.w); }
            const float lf = -(fmaxf(z, 0.f) + __log2f(1.f + exp2f(-fabsf(z))));
            const float w_ = exp2f(z + lf + accl);
            const bf16* vr = P + ((size_t)b * SEQ + s) * PROJW + PC_V + h * 64;
#pragma unroll
            for (int c = 0; c < 8; ++c) { const u32x4 w = *(const u32x4*)(vr + 8 * c);
                o[8 * c] += w_ * bflo(w.x); o[8 * c + 1] += w_ * bfhi(w.x); o[8 * c + 2] += w_ * bflo(w.y); o[8 * c + 3] += w_ * bfhi(w.y); o[8 * c + 4] += w_ * bflo(w.z); o[8 * c + 5] += w_ * bfhi(w.z); o[8 * c + 6] += w_ * bflo(w.w); o[8 * c + 7] += w_ * bfhi(w.w); }
            accl += lf;
            if (accl < -150.f) break;
        }
#pragma unroll
        for (int c = 0; c < 8; ++c) { u32x4 w; w.x = pk2(o[8 * c], o[8 * c + 1]); w.y = pk2(o[8 * c + 2], o[8 * c + 3]); w.z = pk2(o[8 * c + 4], o[8 * c + 5]); w.w = pk2(o[8 * c + 6], o[8 * c + 7]);
            *(u32x4*)(MIX + trow * DM + h * 64 + 8 * c) = w; }
    }
}

namespace sbk {
typedef _Float16 f16x8 __attribute__((ext_vector_type(8)));
typedef float f32x16 __attribute__((ext_vector_type(16)));
typedef short v4i16_t __attribute__((ext_vector_type(4)));
constexpr int LK = 0, LV = 16384, LF = 32768;
__device__ __forceinline__ unsigned pkh(float a, float b) { return __builtin_bit_cast(unsigned, __builtin_amdgcn_cvt_pkrtz(a, b)); }
__device__ __forceinline__ unsigned pkb(float a, float b) { unsigned r; asm volatile("v_cvt_pk_bf16_f32 %0, %1, %2" : "=v"(r) : "v"(a), "v"(b)); return r; }
__device__ __forceinline__ bf16x8 vfrag(const LAS unsigned char* p) {
    const v4i16_t a = __builtin_amdgcn_ds_read_tr16_b64_v4i16((LAS v4i16_t*)(p)), b = __builtin_amdgcn_ds_read_tr16_b64_v4i16((LAS v4i16_t*)(p + 512));
    return (bf16x8){a[0], a[1], a[2], a[3], b[0], b[1], b[2], b[3]};
}
template <bool DIAG>
__device__ __forceinline__ void tile(const LAS unsigned char* kb, const LAS unsigned char* vb, const bf16x8 (&qf)[4], const f16x8 (&tf)[2], const int (&kofs)[4], const int (&vofs)[2], int qr2, f32x16& accB, f32x16 (&o)[2]) {
    f32x16 s0 = {}, s1 = {};
#pragma unroll
    for (int s = 0; s < 4; ++s) { const bf16x8 k0 = *(const LAS bf16x8*)(kb + kofs[s]), k1 = *(const LAS bf16x8*)(kb + 4096 + kofs[s]);
        s0 = __builtin_amdgcn_mfma_f32_32x32x16_bf16(k0, qf[s], s0, 0, 0, 0); s1 = __builtin_amdgcn_mfma_f32_32x32x16_bf16(k1, qf[s], s1, 0, 0, 0); }
    float l0[16], l1[16];
#pragma unroll
    for (int g = 0; g < 16; ++g) {
        const float z0 = fminf(s0[g], 126.f), z1 = fminf(s1[g], 126.f); s0[g] = z0; s1[g] = z1;
        float a0 = -__builtin_amdgcn_logf(1.f + __builtin_amdgcn_exp2f(z0)), a1 = -__builtin_amdgcn_logf(1.f + __builtin_amdgcn_exp2f(z1));
        if (DIAG) { const int ko = 16 * (g >> 3) + (g & 7); if (!(ko < qr2)) a0 = 0.f; if (!(32 + ko < qr2)) a1 = 0.f; }
        l0[g] = a0; l1[g] = a1;
    }
    f16x8 x0[2], x1[2];
#pragma unroll
    for (int t = 0; t < 2; ++t) { u32x4 a, b;
        a.x = pkh(l0[8 * t], l0[8 * t + 1]); a.y = pkh(l0[8 * t + 2], l0[8 * t + 3]); a.z = pkh(l0[8 * t + 4], l0[8 * t + 5]); a.w = pkh(l0[8 * t + 6], l0[8 * t + 7]);
        b.x = pkh(l1[8 * t], l1[8 * t + 1]); b.y = pkh(l1[8 * t + 2], l1[8 * t + 3]); b.z = pkh(l1[8 * t + 4], l1[8 * t + 5]); b.w = pkh(l1[8 * t + 6], l1[8 * t + 7]);
        x0[t] = __builtin_bit_cast(f16x8, a); x1[t] = __builtin_bit_cast(f16x8, b); }
    const f16x8 ones = {(_Float16)1.f, (_Float16)1.f, (_Float16)1.f, (_Float16)1.f, (_Float16)1.f, (_Float16)1.f, (_Float16)1.f, (_Float16)1.f};
    f32x16 y1 = s1 + accB;
    y1 = __builtin_amdgcn_mfma_f32_32x32x16_f16(tf[0], x1[0], y1, 0, 0, 0); y1 = __builtin_amdgcn_mfma_f32_32x32x16_f16(tf[1], x1[1], y1, 0, 0, 0);
    f32x16 u1 = __builtin_amdgcn_mfma_f32_32x32x16_f16(ones, x1[0], accB, 0, 0, 0); u1 = __builtin_amdgcn_mfma_f32_32x32x16_f16(ones, x1[1], u1, 0, 0, 0);
    f32x16 y0 = s0 + u1;
    y0 = __builtin_amdgcn_mfma_f32_32x32x16_f16(tf[0], x0[0], y0, 0, 0, 0); y0 = __builtin_amdgcn_mfma_f32_32x32x16_f16(tf[1], x0[1], y0, 0, 0, 0);
    accB = __builtin_amdgcn_mfma_f32_32x32x16_f16(ones, x0[0], u1, 0, 0, 0); accB = __builtin_amdgcn_mfma_f32_32x32x16_f16(ones, x0[1], accB, 0, 0, 0);
#pragma unroll
    for (int g = 0; g < 16; ++g) {
        float w0 = __builtin_amdgcn_exp2f(y0[g]), w1 = __builtin_amdgcn_exp2f(y1[g]);
        if (DIAG) { const int ko = 16 * (g >> 3) + (g & 7); if (!(ko < qr2)) w0 = 0.f; if (!(32 + ko < qr2)) w1 = 0.f; }
        y0[g] = w0; y1[g] = w1;
    }
    bf16x8 wf0[2], wf1[2];
#pragma unroll
    for (int t = 0; t < 2; ++t) { u32x4 a, b;
        a.x = pkb(y0[8 * t], y0[8 * t + 1]); a.y = pkb(y0[8 * t + 2], y0[8 * t + 3]); a.z = pkb(y0[8 * t + 4], y0[8 * t + 5]); a.w = pkb(y0[8 * t + 6], y0[8 * t + 7]);
        b.x = pkb(y1[8 * t], y1[8 * t + 1]); b.y = pkb(y1[8 * t + 2], y1[8 * t + 3]); b.z = pkb(y1[8 * t + 4], y1[8 * t + 5]); b.w = pkb(y1[8 * t + 6], y1[8 * t + 7]);
        wf0[t] = __builtin_bit_cast(bf16x8, a); wf1[t] = __builtin_bit_cast(bf16x8, b); }
#pragma unroll
    for (int c = 0; c < 2; ++c) {
#pragma unroll
        for (int t = 0; t < 2; ++t) {
            o[c] = __builtin_amdgcn_mfma_f32_32x32x16_bf16(vfrag(vb + vofs[c] + 2048 * t), wf0[t], o[c], 0, 0, 0);
            o[c] = __builtin_amdgcn_mfma_f32_32x32x16_bf16(vfrag(vb + vofs[c] + 4096 + 2048 * t), wf1[t], o[c], 0, 0, 0); }
    }
}
}
__device__ __forceinline__ void phase_sb_fast(Frame& F0) {
    PHASE_FRAME(F0);
    using namespace sbk;
    unsigned char* ws = F.ws; asm volatile("" : "+s"(ws));
    const bf16* P = (const bf16*)(ws + WS_PROJ); bf16* MIX = (bf16*)(ws + WS_MIX);
    const int tid = F.tid, lane = F.lane, w = F.wave, r = lane & 31, h = lane >> 5;
    LAS unsigned char* lds = F.lds;
    const int pr = (r & ~12) | ((r & 4) << 1) | ((r & 8) >> 1), sw = (pr >> 1) & 7;
    int kofs[4], vofs[2];
#pragma unroll
    for (int s = 0; s < 4; ++s) kofs[s] = pr * 128 + (((2 * s + h) ^ sw) << 4);
    { const int q4 = (lane & 15) >> 2, p4 = lane & 3, gd = (lane >> 4) & 1;
#pragma unroll
      for (int c = 0; c < 2; ++c) { int ch = 4 * c + 2 * gd + (p4 >> 1); ch ^= ((q4 >> 1) << 2); vofs[c] = (8 * h + q4) * 128 + (p4 & 1) * 8 + ch * 16; } }
    f16x8 tf[2];
#pragma unroll
    for (int t = 0; t < 2; ++t) { u32x4 a; unsigned wv[4];
#pragma unroll
        for (int j = 0; j < 4; ++j) { const int k0 = 16 * t + 8 * h + 2 * j; wv[j] = (k0 >= pr ? 0x3C00u : 0u) | (k0 + 1 >= pr ? 0x3C000000u : 0u); }
        a.x = wv[0]; a.y = wv[1]; a.z = wv[2]; a.w = wv[3]; tf[t] = __builtin_bit_cast(f16x8, a); }
    const int srow = tid >> 3, sch = tid & 7;
    const int skofs = LK + srow * 128 + ((sch ^ ((srow >> 1) & 7)) << 4), svofs = LV + srow * 128 + ((sch ^ (((srow >> 1) & 1) << 2)) << 4);
    LAS unsigned* fl = (LAS unsigned*)(lds + LF);
    for (int u = F.vcu; u < NB * SBH * 16; u += F.G) {
        const int qb = u & 15, hd = (u >> 4) & 7, b = u >> 7;
        const size_t tokbase = (size_t)b * SEQ; const int q0 = qb * 256, qs = q0 + 32 * w, dtw = qs >> 6, jt_hi = (q0 + 255) >> 6;
        bf16x8 qf[4];
#pragma unroll
        for (int s = 0; s < 4; ++s) qf[s] = *(const bf16x8*)(P + (tokbase + qs + r) * PROJW + PC_Q + hd * 64 + 16 * s + 8 * h);
        const bf16* kg = P + (tokbase + srow) * PROJW + PC_K + hd * 64 + sch * 8; const bf16* vg = P + (tokbase + srow) * PROJW + PC_V + hd * 64 + sch * 8;
        f32x16 o[2]; o[0] = f32x16{}; o[1] = f32x16{}; f32x16 accB = {};
        bool done = false;
        { const u32x4 kr = *(const u32x4*)(kg + (size_t)jt_hi * 64 * PROJW), vr = *(const u32x4*)(vg + (size_t)jt_hi * 64 * PROJW);
          *(LAS u32x4*)(lds + skofs) = kr; *(LAS u32x4*)(lds + svofs) = vr; }
        __syncthreads();
        int it = 0;
#pragma unroll 1
        for (int jt = jt_hi; jt >= 0; --jt, ++it) {
            if (it > 0) { unsigned nd = 0;
#pragma unroll
                for (int j = 0; j < 8; ++j) nd += fl[((it - 1) & 1) * 8 + j];
                if (__builtin_amdgcn_readfirstlane(nd) == 8u) break; }
            const int cur = (it & 1) * 8192, nxb = ((it + 1) & 1) * 8192;
            u32x4 kr = {}, vr = {};
            if (jt > 0) { kr = *(const u32x4*)(kg + (size_t)(jt - 1) * 64 * PROJW); vr = *(const u32x4*)(vg + (size_t)(jt - 1) * 64 * PROJW); }
            if (!done && jt <= dtw) {
                const int qr2 = qs + r - 64 * jt - 8 * h;
                if (jt == dtw) tile<true>(lds + LK + cur, lds + LV + cur, qf, tf, kofs, vofs, qr2, accB, o);
                else tile<false>(lds + LK + cur, lds + LV + cur, qf, tf, kofs, vofs, qr2, accB, o);
                done = __all(accB[0] < -150.f);
            }
            if (lane == 0) fl[(it & 1) * 8 + w] = done ? 1u : 0u;
            if (jt > 0) { *(LAS u32x4*)(lds + nxb + skofs) = kr; *(LAS u32x4*)(lds + nxb + svofs) = vr; }
            __syncthreads();
        }
        bf16* orow = MIX + (tokbase + qs + r) * DM + hd * 64 + 4 * h;
#pragma unroll
        for (int c = 0; c < 2; ++c)
#pragma unroll
            for (int gg = 0; gg < 4; ++gg) { u32x2 v; v.x = pkb(o[c][4 * gg], o[c][4 * gg + 1]); v.y = pkb(o[c][4 * gg + 2], o[c][4 * gg + 3]); *(u32x2*)(orow + 32 * c + 8 * gg) = v; }
        __syncthreads();
    }
}

__device__ __forceinline__ void phase_gla_naive(Frame& F0) {
    PHASE_FRAME(F0);
    const bf16* P = (const bf16*)(F.ws + WS_PROJ); const float* LG = (const float*)(F.ws + WS_LG); float* OB = (float*)(F.ws + WS_OB);
    for (int idx = F.vcu * NTHR + F.tid; idx < NB * GH * GDV; idx += F.G * NTHR) {
        const int vv = idx & 127, g = (idx >> 7) & 3, b = idx >> 9;
        float S[64];
#pragma unroll
        for (int d = 0; d < 64; ++d) S[d] = 0.f;
        for (int t = 0; t < SEQ; ++t) {
            const size_t trow = (size_t)b * SEQ + t;
            const float vt = bf2f(P[trow * PROJW + PC_GV + g * GDV + vv]);
            float o = 0.f;
#pragma unroll
            for (int c = 0; c < 8; ++c) { const u32x4 kw = *(const u32x4*)(P + trow * PROJW + PC_GK + g * 64 + 8 * c), qw = *(const u32x4*)(P + trow * PROJW + PC_GQ + g * 64 + 8 * c);
                const f32x4 l0 = *(const f32x4*)(LG + trow * GKW + g * 64 + 8 * c), l1 = *(const f32x4*)(LG + trow * GKW + g * 64 + 8 * c + 4);
                S[8 * c]     = __expf(l0[0]) * S[8 * c]     + bflo(kw.x) * vt; o += bflo(qw.x) * S[8 * c];
                S[8 * c + 1] = __expf(l0[1]) * S[8 * c + 1] + bfhi(kw.x) * vt; o += bfhi(qw.x) * S[8 * c + 1];
                S[8 * c + 2] = __expf(l0[2]) * S[8 * c + 2] + bflo(kw.y) * vt; o += bflo(qw.y) * S[8 * c + 2];
                S[8 * c + 3] = __expf(l0[3]) * S[8 * c + 3] + bfhi(kw.y) * vt; o += bfhi(qw.y) * S[8 * c + 3];
                S[8 * c + 4] = __expf(l1[0]) * S[8 * c + 4] + bflo(kw.z) * vt; o += bflo(qw.z) * S[8 * c + 4];
                S[8 * c + 5] = __expf(l1[1]) * S[8 * c + 5] + bfhi(kw.z) * vt; o += bfhi(qw.z) * S[8 * c + 5];
                S[8 * c + 6] = __expf(l1[2]) * S[8 * c + 6] + bflo(kw.w) * vt; o += bflo(qw.w) * S[8 * c + 6];
                S[8 * c + 7] = __expf(l1[3]) * S[8 * c + 7] + bfhi(kw.w) * vt; o += bfhi(qw.w) * S[8 * c + 7];
                asm volatile("" ::: "memory"); }
            OB[trow * GVW + g * GDV + vv] = o;
        }
    }
}
__device__ __forceinline__ void phase_gla_out(Frame& F0, int l) {
    PHASE_FRAME(F0);
    const bf16* P = (const bf16*)(F.ws + WS_PROJ); const float* OB = (const float*)(F.ws + WS_OB); bf16* MIX = (bf16*)(F.ws + WS_MIX);
    const int gw = F.vcu * NWAVES + F.wave, NGW = F.G * NWAVES, lane = F.lane;
    for (int it = gw; it < NTOK * GH; it += NGW) {
        const int t = it >> 2, g = it & 3;
        const f32x2 o = *(const f32x2*)(OB + (size_t)t * GVW + g * GDV + 2 * lane);
        const float rstd = 1.f / sqrtf(wave_sum(o[0] * o[0] + o[1] * o[1]) * (1.f / GDV) + EPS);
        const unsigned gr = *(const unsigned*)(P + (size_t)t * PROJW + PC_GR + g * GDV + 2 * lane);
        const f32x2 gn = *(const f32x2*)(F_GLAGAIN + l * GDV + 2 * lane);
        *(unsigned*)(MIX + (size_t)t * DM + SBW + g * GDV + 2 * lane) = pk2(o[0] * rstd * gn[0] * bflo(gr), o[1] * rstd * gn[1] * bfhi(gr));
    }
}


namespace glak {
using sbk::f16x8; using sbk::f32x16; using sbk::pkb; using sbk::v4i16_t;
__device__ __forceinline__ float bfu_lo(unsigned w) { return __builtin_bit_cast(float, w << 16); }
__device__ __forceinline__ float bfu_hi(unsigned w) { return __builtin_bit_cast(float, w & 0xffff0000u); }
__device__ __forceinline__ bf16x8 scale8(u32x4 q, const float (&e)[8]) {
    u32x4 o; o.x = pkb(bfu_lo(q.x) * e[0], bfu_hi(q.x) * e[1]); o.y = pkb(bfu_lo(q.y) * e[2], bfu_hi(q.y) * e[3]); o.z = pkb(bfu_lo(q.z) * e[4], bfu_hi(q.z) * e[5]); o.w = pkb(bfu_lo(q.w) * e[6], bfu_hi(q.w) * e[7]);
    return __builtin_bit_cast(bf16x8, o);
}
__device__ __forceinline__ void prep(const float* GLR, const float* wg, const float* bg, size_t tok0, int r, int h, int pr, f32x16 (&b)[2][2]) {
    f16x8 af[2], bf[2];
#pragma unroll
    for (int tb = 0; tb < 2; ++tb) { const f32x4 a0 = *(const f32x4*)(GLR + (tok0 + 32 * tb + pr) * GRANK + 8 * h), a1 = *(const f32x4*)(GLR + (tok0 + 32 * tb + pr) * GRANK + 8 * h + 4);
        af[tb] = (f16x8){(_Float16)a0[0], (_Float16)a0[1], (_Float16)a0[2], (_Float16)a0[3], (_Float16)a1[0], (_Float16)a1[1], (_Float16)a1[2], (_Float16)a1[3]}; }
    float bias[2];
#pragma unroll
    for (int db = 0; db < 2; ++db) { float wv[8];
#pragma unroll
        for (int e = 0; e < 8; ++e) wv[e] = wg[(size_t)(8 * h + e) * GKW + 32 * db + r];
        bf[db] = (f16x8){(_Float16)wv[0], (_Float16)wv[1], (_Float16)wv[2], (_Float16)wv[3], (_Float16)wv[4], (_Float16)wv[5], (_Float16)wv[6], (_Float16)wv[7]};
        bias[db] = bg[32 * db + r]; }
    f16x8 lt[2];
#pragma unroll
    for (int t = 0; t < 2; ++t) { u32x4 a; unsigned wv[4];
#pragma unroll
        for (int j = 0; j < 4; ++j) { const int k0 = 16 * t + 8 * h + 2 * j; wv[j] = (k0 <= pr ? 0x3C00u : 0u) | (k0 + 1 <= pr ? 0x3C000000u : 0u); }
        a.x = wv[0]; a.y = wv[1]; a.z = wv[2]; a.w = wv[3]; lt[t] = __builtin_bit_cast(f16x8, a); }
    const f16x8 ones = {(_Float16)1.f, (_Float16)1.f, (_Float16)1.f, (_Float16)1.f, (_Float16)1.f, (_Float16)1.f, (_Float16)1.f, (_Float16)1.f};
#pragma unroll
    for (int db = 0; db < 2; ++db) {
        f16x8 x[2][2];
#pragma unroll
        for (int tb = 0; tb < 2; ++tb) {
            f32x16 p = {}; p = __builtin_amdgcn_mfma_f32_32x32x16_f16(af[tb], bf[db], p, 0, 0, 0);
            float ls[16];
#pragma unroll
            for (int g = 0; g < 16; ++g) { const float v = p[g] + bias[db];
                ls[g] = -(fmaxf(-v, 0.f) + 0.6931471805599453f * __builtin_amdgcn_logf(1.f + __builtin_amdgcn_exp2f(-fabsf(v) * LOG2E))); }
#pragma unroll
            for (int t = 0; t < 2; ++t) x[tb][t] = (f16x8){(_Float16)ls[8 * t], (_Float16)ls[8 * t + 1], (_Float16)ls[8 * t + 2], (_Float16)ls[8 * t + 3], (_Float16)ls[8 * t + 4], (_Float16)ls[8 * t + 5], (_Float16)ls[8 * t + 6], (_Float16)ls[8 * t + 7]};
        }
        f32x16 c0 = {}, c1 = {};
        c0 = __builtin_amdgcn_mfma_f32_32x32x16_f16(lt[0], x[0][0], c0, 0, 0, 0); c0 = __builtin_amdgcn_mfma_f32_32x32x16_f16(lt[1], x[0][1], c0, 0, 0, 0);
        c1 = __builtin_amdgcn_mfma_f32_32x32x16_f16(ones, x[0][0], c1, 0, 0, 0); c1 = __builtin_amdgcn_mfma_f32_32x32x16_f16(ones, x[0][1], c1, 0, 0, 0);
        c1 = __builtin_amdgcn_mfma_f32_32x32x16_f16(lt[0], x[1][0], c1, 0, 0, 0); c1 = __builtin_amdgcn_mfma_f32_32x32x16_f16(lt[1], x[1][1], c1, 0, 0, 0);
        b[0][db] = c0 * (1.f / 16.f); b[1][db] = c1 * (1.f / 16.f);
    }
}
}

__device__ __forceinline__ void phase_gla_g1(Frame& F0, int l) {
    PHASE_FRAME(F0);
    using namespace glak;
    unsigned char* ws = F.ws; asm volatile("" : "+s"(ws));
    const bf16* P = (const bf16*)(ws + WS_PROJ); const bf16* GVT = (const bf16*)(ws + WS_GVT); const float* GLR = (const float*)(ws + WS_GLR);
    float* ST = (float*)(ws + WS_ST); float* DEC = (float*)(ws + WS_DECAY);
    const int lane = F.lane, r = lane & 31, h = lane >> 5, pr = (r & ~12) | ((r & 4) << 1) | ((r & 8) >> 1);
    LAS unsigned char* wl = F.lds + F.wave * GLA_WL;
    int vofs[2];
    { const int q4 = (lane & 15) >> 2, p4 = lane & 3, gd = (lane >> 4) & 1;
#pragma unroll
      for (int c = 0; c < 2; ++c) { int ch = 4 * c + 2 * gd + (p4 >> 1); ch ^= ((q4 >> 1) << 2); vofs[c] = (8 * h + q4) * 128 + (p4 & 1) * 8 + ch * 16; } }
    const float* wgk2 = F_WGK2 + (size_t)l * GRANK * GKW; const float* bgk = F_BGK + l * GKW;
    for (int cid = F.vcu * NWAVES + F.wave; cid < NB * GH * 64; cid += F.G * NWAVES) {
        const int n = cid & 63, g = (cid >> 6) & 3, b = cid >> 8; const size_t tok0 = (size_t)b * SEQ + 64 * n;
#pragma unroll
        for (int j = 0; j < 8; ++j) { const int idx = j * 64 + lane, row = idx >> 3, ch = idx & 7;
            const u32x4 kv = *(const u32x4*)(P + (tok0 + row) * PROJW + PC_GK + g * 64 + ch * 8);
            *(LAS u32x4*)(wl + row * 128 + ((ch ^ (((row >> 1) & 1) << 2)) << 4)) = kv; }
        f32x16 bb[2][2];
        prep(GLR, wgk2 + g * 64, bgk + g * 64, tok0, r, h, pr, bb);
        asm volatile("s_waitcnt lgkmcnt(0)" ::: "memory");
#pragma unroll
        for (int db = 0; db < 2; ++db) {
            const float bl = __shfl(bb[1][db][15], r + 32);
            if (h == 0) DEC[(size_t)cid * 64 + 32 * db + r] = __expf(bl);
            f32x16 acc[4]; acc[0] = f32x16{}; acc[1] = f32x16{}; acc[2] = f32x16{}; acc[3] = f32x16{};
#pragma unroll
            for (int tb = 0; tb < 2; ++tb)
#pragma unroll
                for (int s2 = 0; s2 < 2; ++s2) {
                    const LAS unsigned char* kp = wl + vofs[db] + 4096 * tb + 2048 * s2;
                    const v4i16_t ka = __builtin_amdgcn_ds_read_tr16_b64_v4i16((LAS v4i16_t*)(kp)), kb = __builtin_amdgcn_ds_read_tr16_b64_v4i16((LAS v4i16_t*)(kp + 512));
                    float e[8];
#pragma unroll
                    for (int j = 0; j < 8; ++j) e[j] = __expf(bl - bb[tb][db][8 * s2 + j]);
                    u32x4 kq; kq.x = (unsigned)(unsigned short)ka[0] | ((unsigned)(unsigned short)ka[1] << 16); kq.y = (unsigned)(unsigned short)ka[2] | ((unsigned)(unsigned short)ka[3] << 16);
                    kq.z = (unsigned)(unsigned short)kb[0] | ((unsigned)(unsigned short)kb[1] << 16); kq.w = (unsigned)(unsigned short)kb[2] | ((unsigned)(unsigned short)kb[3] << 16);
                    const bf16x8 kd = scale8(kq, e);
#pragma unroll
                    for (int vb = 0; vb < 4; ++vb) { const bf16x8 vt = *(const bf16x8*)(GVT + (size_t)(g * GDV + 32 * vb + r) * NTOK + tok0 + 32 * tb + 16 * s2 + 8 * h);
                        acc[vb] = __builtin_amdgcn_mfma_f32_32x32x16_bf16(vt, kd, acc[vb], 0, 0, 0); }
                }
#pragma unroll
            for (int vb = 0; vb < 4; ++vb)
#pragma unroll
                for (int gq = 0; gq < 16; ++gq) ST[((size_t)cid * GDV + 32 * vb + (gq & 3) + 8 * (gq >> 2) + 4 * h) * GDK + 32 * db + r] = acc[vb][gq];
        }
        asm volatile("s_waitcnt lgkmcnt(0)" ::: "memory");
    }
}
__device__ __forceinline__ void phase_gla_g2(Frame& F0) {
    PHASE_FRAME(F0);
    unsigned char* ws = F.ws; asm volatile("" : "+s"(ws));
    float* ST = (float*)(ws + WS_ST); const float* DEC = (const float*)(ws + WS_DECAY);
    for (int idx = F.vcu * NTHR + F.tid; idx < NB * GH * GDV * 32; idx += F.G * NTHR) {
        const int d2 = idx & 31, v = (idx >> 5) & 127, bg = idx >> 12;
        f32x2 carry = {0.f, 0.f};
        float* p = ST + (((size_t)bg * 64) * GDV + v) * GDK + 2 * d2; const float* dp = DEC + (size_t)bg * 64 * 64 + 2 * d2;
#pragma unroll 8
        for (int n = 0; n < 64; ++n) { const f32x2 kv = *(const f32x2*)(p + (size_t)n * GDV * GDK), dc = *(const f32x2*)(dp + n * 64);
            *(f32x2*)(p + (size_t)n * GDV * GDK) = carry; carry = dc * carry + kv; }
    }
}
__device__ __forceinline__ void phase_gla_g3(Frame& F0, int l) {
    PHASE_FRAME(F0);
    using namespace glak;
    unsigned char* ws = F.ws; asm volatile("" : "+s"(ws));
    const bf16* P = (const bf16*)(ws + WS_PROJ); const bf16* GVT = (const bf16*)(ws + WS_GVT); const float* GLR = (const float*)(ws + WS_GLR);
    const float* ST = (const float*)(ws + WS_ST); bf16* MIX = (bf16*)(ws + WS_MIX);
    const int lane = F.lane, r = lane & 31, h = lane >> 5, pr = (r & ~12) | ((r & 4) << 1) | ((r & 8) >> 1);
    LAS unsigned char* wl = F.lds + F.wave * GLA_WL;
    const float* wgk2 = F_WGK2 + (size_t)l * GRANK * GKW; const float* bgk = F_BGK + l * GKW; const float* gain = F_GLAGAIN + l * GDV;
    for (int cid = F.vcu * NWAVES + F.wave; cid < NB * GH * 64; cid += F.G * NWAVES) {
        const int n = cid & 63, g = (cid >> 6) & 3, b = cid >> 8; const size_t tok0 = (size_t)b * SEQ + 64 * n;
        { f32x16 bb[2][2];
          prep(GLR, wgk2 + g * 64, bgk + g * 64, tok0, r, h, pr, bb);
          LAS unsigned char* wb = wl + (8 * h) * 272 + r * 4;
#pragma unroll
          for (int tb = 0; tb < 2; ++tb)
#pragma unroll
              for (int db = 0; db < 2; ++db)
#pragma unroll
                  for (int gq = 0; gq < 16; ++gq) *(LAS float*)(wb + (32 * tb + 16 * (gq >> 3) + (gq & 7)) * 272 + 128 * db) = bb[tb][db][gq];
        }
        asm volatile("s_waitcnt lgkmcnt(0)" ::: "memory");
#pragma unroll 1
        for (int tb = 0; tb < 2; ++tb) {
            bf16x8 qd[4];
            { const int t = 32 * tb + r; const LAS unsigned char* rq = wl + r * 272 + 32 * h;
#pragma unroll
              for (int kd = 0; kd < 4; ++kd) {
                  const f32x4 b0 = *(const LAS f32x4*)(rq + 32 * tb * 272 + 64 * kd), b1 = *(const LAS f32x4*)(rq + 32 * tb * 272 + 64 * kd + 16);
                  float e[8] = {__expf(b0[0]), __expf(b0[1]), __expf(b0[2]), __expf(b0[3]), __expf(b1[0]), __expf(b1[1]), __expf(b1[2]), __expf(b1[3])};
                  const u32x4 q = *(const u32x4*)(P + (tok0 + t) * PROJW + PC_GQ + g * 64 + 16 * kd + 8 * h);
                  qd[kd] = scale8(q, e); } }
            f32x16 o[4]; o[0] = f32x16{}; o[1] = f32x16{}; o[2] = f32x16{}; o[3] = f32x16{};
#pragma unroll 1
            for (int sb = 0; sb <= tb; ++sb) {
                f32x16 pt = {};
                { const int srow = 32 * sb + pr; const LAS unsigned char* rk = wl + pr * 272 + 32 * h;
#pragma unroll
                  for (int kd = 0; kd < 4; ++kd) {
                      const f32x4 b0 = *(const LAS f32x4*)(rk + 32 * sb * 272 + 64 * kd), b1 = *(const LAS f32x4*)(rk + 32 * sb * 272 + 64 * kd + 16);
                      float e[8] = {__expf(-b0[0]), __expf(-b0[1]), __expf(-b0[2]), __expf(-b0[3]), __expf(-b1[0]), __expf(-b1[1]), __expf(-b1[2]), __expf(-b1[3])};
                      const u32x4 k = *(const u32x4*)(P + (tok0 + srow) * PROJW + PC_GK + g * 64 + 16 * kd + 8 * h);
                      pt = __builtin_amdgcn_mfma_f32_32x32x16_bf16(scale8(k, e), qd[kd], pt, 0, 0, 0); } }
                if (sb == tb) {
#pragma unroll
                    for (int gq = 0; gq < 16; ++gq) if (16 * (gq >> 3) + 8 * h + (gq & 7) > r) pt[gq] = 0.f; }
#pragma unroll
                for (int s2 = 0; s2 < 2; ++s2) { u32x4 a; a.x = pkb(pt[8 * s2], pt[8 * s2 + 1]); a.y = pkb(pt[8 * s2 + 2], pt[8 * s2 + 3]); a.z = pkb(pt[8 * s2 + 4], pt[8 * s2 + 5]); a.w = pkb(pt[8 * s2 + 6], pt[8 * s2 + 7]);
                    const bf16x8 pf = __builtin_bit_cast(bf16x8, a);
#pragma unroll
                    for (int vb = 0; vb < 4; ++vb) { const bf16x8 vt = *(const bf16x8*)(GVT + (size_t)(g * GDV + 32 * vb + r) * NTOK + tok0 + 32 * sb + 16 * s2 + 8 * h);
                        o[vb] = __builtin_amdgcn_mfma_f32_32x32x16_bf16(vt, pf, o[vb], 0, 0, 0); }
                    asm volatile("" ::: "memory"); }
            }
#pragma unroll
            for (int vb = 0; vb < 4; ++vb)
#pragma unroll
                for (int kd = 0; kd < 4; ++kd) { const float* sp = ST + ((size_t)cid * GDV + 32 * vb + r) * GDK + 16 * kd + 8 * h;
                    const f32x4 s0 = *(const f32x4*)sp, s1 = *(const f32x4*)(sp + 4);
                    u32x4 a; a.x = pkb(s0[0], s0[1]); a.y = pkb(s0[2], s0[3]); a.z = pkb(s1[0], s1[1]); a.w = pkb(s1[2], s1[3]);
                    o[vb] = __builtin_amdgcn_mfma_f32_32x32x16_bf16(__builtin_bit_cast(bf16x8, a), qd[kd], o[vb], 0, 0, 0);
                    if (kd & 1) asm volatile("" ::: "memory"); }
            float ss = 0.f;
#pragma unroll
            for (int vb = 0; vb < 4; ++vb)
#pragma unroll
                for (int gq = 0; gq < 16; ++gq) ss += o[vb][gq] * o[vb][gq];
            ss += __shfl_xor(ss, 32);
            const float rstd = __builtin_amdgcn_rsqf(ss * (1.f / GDV) + EPS);
            const size_t trow = tok0 + 32 * tb + r;
#pragma unroll
            for (int vb = 0; vb < 4; ++vb)
#pragma unroll
                for (int gg = 0; gg < 4; ++gg) { const int v = 32 * vb + 8 * gg + 4 * h;
                    const f32x4 gn = *(const f32x4*)(gain + v); const u32x2 gr = *(const u32x2*)(P + trow * PROJW + PC_GR + g * GDV + v);
                    u32x2 ov; ov.x = pkb(o[vb][4 * gg] * rstd * gn[0] * bfu_lo(gr.x), o[vb][4 * gg + 1] * rstd * gn[1] * bfu_hi(gr.x));
                    ov.y = pkb(o[vb][4 * gg + 2] * rstd * gn[2] * bfu_lo(gr.y), o[vb][4 * gg + 3] * rstd * gn[3] * bfu_hi(gr.y));
                    *(u32x2*)(MIX + trow * DM + SBW + g * GDV + v) = ov; }
        }
        asm volatile("s_waitcnt lgkmcnt(0)" ::: "memory");
    }
}

constexpr int PH_PER_LAYER = 10, PH_TOTAL = 2 + NL * PH_PER_LAYER;
struct Args { const float* in[20]; float* out; unsigned char* ws; int ph_lo, ph_hi, use_bar, pad; };
template <unsigned MASK>
__global__ void __launch_bounds__(NTHR, 2) fwd_kernel(Args args) {
    extern __shared__ __attribute__((aligned(16))) unsigned char lds[];
    Frame F;
    F.lds = (LAS unsigned char*)lds;
    F.MISC = (volatile LAS unsigned*)(F.lds + MISC_OFF);
    F.tid = threadIdx.x; F.lane = F.tid & 63; F.wave = __builtin_amdgcn_readfirstlane(F.tid >> 6);
    F.G = gridDim.x; { const int bx = blockIdx.x; F.vcu = (F.G % 8 == 0) ? (bx % 8) * (F.G / 8) + bx / 8 : bx; }
    F.out = args.out; F.ws = args.ws; F.ctl = (unsigned*)(args.ws + WS_CTL);
    for (int u = F.tid; u < (LDS_BYTES - LDSCTL_OFF) / 4; u += NTHR) ((LAS unsigned*)(F.lds + LDSCTL_OFF))[u] = 0u;
    __syncthreads();
    if (F.tid < 20) { const unsigned long long pv = (unsigned long long)args.in[F.tid]; LAS unsigned* p = (LAS unsigned*)(F.lds + PTAB_OFF) + 2 * F.tid; p[0] = (unsigned)pv; p[1] = (unsigned)(pv >> 32); }
    __syncthreads();
    XcdBarrier bar; bar.bar = F.ctl + CW_BAR; bar.x = 0; bar.st = nullptr;
    if (args.use_bar) bar = xcd_barrier_post(F.ctl + CW_BAR, F.MISC + 8);
    const int lo = args.ph_lo, hi = args.ph_hi;
#define INB(k, bit) ((((MASK) >> (bit)) & 1u) && lo <= (k) && (k) < hi)
#define SEAM(k) do { if (MASK == 0xFFFu && lo <= (k) && (k) + 1 < hi) xcd_barrier(bar); } while (0)
    if (INB(0, 10)) { p0_prologue(F); SEAM(0); }
    for (int l = 0; l < NL; ++l) {
        const int pb = 1 + l * PH_PER_LAYER;
        const float* mod = (const float*)(F.ws + WS_MOD) + (size_t)l * NB * NMOD * DM;
        if (INB(pb + 0, 0)) {
#ifdef NORM_NAIVE
            phase_norm_a(F, l);
#else
            phase_norm_fast<0>(F, l);
#endif
            SEAM(pb + 0); }
        if (INB(pb + 1, 1)) {
            pg8::Gemm g{(const bf16*)(F.ws + WS_H), (const bf16*)(F.ws + WS_WIN) + (size_t)l * PROJW * DM, DM, nullptr};
#ifdef GLA_NAIVE
            pg8::StaticOrder S; S.init(NTOK, PROJW, F.G, (int)blockIdx.x);
            pg8::EpiProj E{(bf16*)(F.ws + WS_PROJ), F_QGAIN + l * SBD, F_KGAIN + l * SBD};
            pg8::gemm_phase<pg8::EpiProj, pg8::StaticOrder, false, true, true>(F.lds, g, S, E);
#else
            pg8::StaticOrder S; S.init(NTOK, PROJW - 512, F.G, (int)blockIdx.x); S.skip_from = 8; S.skip_n = 2;
            pg8::EpiProj E{(bf16*)(F.ws + WS_PROJ), F_QGAIN + l * SBD, F_KGAIN + l * SBD};
            pg8::gemm_phase<pg8::EpiProj, pg8::StaticOrder, false, true, true>(F.lds, g, S, E);
            pg8::Gemm g2{(const bf16*)(F.ws + WS_WIN) + ((size_t)l * PROJW + PC_GV) * DM, (const bf16*)(F.ws + WS_H), DM, nullptr};
            pg8::StaticOrder S2; S2.init(GVW, NTOK, F.G, (int)blockIdx.x);
            pg8::EpiStore E2{(bf16*)(F.ws + WS_GVT), NTOK};
            pg8::gemm_phase<pg8::EpiStore, pg8::StaticOrder, false, true, true>(F.lds, g2, S2, E2);
#endif
            SEAM(pb + 1);
        }
        if (INB(pb + 2, 2)) {
#ifdef GLA_NAIVE
            phase_logdecay(F, l);
#else
            phase_gla_g1(F, l);
#endif
#ifdef SB_NAIVE
            phase_sb_naive(F);
#else
            phase_sb_fast(F);
#endif
            SEAM(pb + 2); }
#ifdef GLA_NAIVE
        if (INB(pb + 3, 3)) { phase_gla_naive(F); SEAM(pb + 3); }
        if (INB(pb + 4, 4)) { phase_gla_out(F, l); SEAM(pb + 4); }
#else
        if (INB(pb + 3, 3)) { phase_gla_g2(F); SEAM(pb + 3); }
        if (INB(pb + 4, 4)) { phase_gla_g3(F, l); SEAM(pb + 4); }
#endif
        if (INB(pb + 5, 5)) {
            pg8::Gemm g{(const bf16*)(F.ws + WS_MIX), (const bf16*)(F.ws + WS_WOUT) + (size_t)l * DM * DM, DM, nullptr};
            pg8::StaticOrder S; S.init(NTOK, DM, F.G, (int)blockIdx.x);
            pg8::EpiResid E{l == 0 ? F_X : F.out, F.out, mod + 2 * DM};
            pg8::gemm_phase<pg8::EpiResid, pg8::StaticOrder, false, true, true>(F.lds, g, S, E);
            SEAM(pb + 5);
        }
        if (INB(pb + 6, 6)) {
#ifdef NORM_NAIVE
            phase_norm_e(F, l);
#else
            phase_norm_fast<1>(F, l);
#endif
            SEAM(pb + 6); }
        if (INB(pb + 7, 7)) { phase_pad_lists(F, l); SEAM(pb + 7); }
        if (INB(pb + 8, 8)) {
            tile_bases(F, l);
            pg8::Gemm g{(const bf16*)(F.ws + WS_H), (const bf16*)(F.ws + WS_W1) + (size_t)l * NEXP * 512 * DM, DM, (const int*)(F.ws + WS_TOKOF)};
            pg8::GroupedOrder S{(const LAS int*)(F.lds + LDSCTL_OFF), 2, F.G, (int)blockIdx.x};
            pg8::EpiMoeAct E{(bf16*)(F.ws + WS_ACT), (const float*)(F.ws + WS_SLOTW)};
            pg8::gemm_phase<pg8::EpiMoeAct, pg8::GroupedOrder, true, true, true>(F.lds, g, S, E);
            SEAM(pb + 8);
        }
        if (INB(pb + 9, 9)) {
            tile_bases(F, l);
            pg8::Gemm g{(const bf16*)(F.ws + WS_ACT), (const bf16*)(F.ws + WS_W2) + (size_t)l * NEXP * DM * DEXP, DEXP, nullptr};
            pg8::GroupedOrder S{(const LAS int*)(F.lds + LDSCTL_OFF), 4, F.G, (int)blockIdx.x};
            pg8::EpiStore E{(bf16*)(F.ws + WS_Y), DM};
            pg8::gemm_phase<pg8::EpiStore, pg8::GroupedOrder, false, true, true>(F.lds, g, S, E);
            SEAM(pb + 9);
        }
    }
    if (INB(PH_TOTAL - 1, 11)) phase_norm_a(F, NL);
#undef INB
#undef SEAM
}

#ifndef N_LAUNCH_MODE
#define N_LAUNCH_MODE 1
#endif
static const void* kfun(int j) {
    switch (j) {
        case 0: return (const void*)fwd_kernel<1u << 0>; case 1: return (const void*)fwd_kernel<1u << 1>; case 2: return (const void*)fwd_kernel<1u << 2>; case 3: return (const void*)fwd_kernel<1u << 3>;
        case 4: return (const void*)fwd_kernel<1u << 4>; case 5: return (const void*)fwd_kernel<1u << 5>; case 6: return (const void*)fwd_kernel<1u << 6>; case 7: return (const void*)fwd_kernel<1u << 7>;
        case 8: return (const void*)fwd_kernel<1u << 8>; case 9: return (const void*)fwd_kernel<1u << 9>; case 10: return (const void*)fwd_kernel<1u << 10>; case 11: return (const void*)fwd_kernel<1u << 11>;
#if N_LAUNCH_MODE == 1
        default: return (const void*)fwd_kernel<0xFFFu>;
#else
        default: return (const void*)fwd_kernel<1u << 11>;
#endif
    }
}
extern "C" void kernel_launch(void* const* d_in, const int* in_sizes, int n_in, void* d_out, int out_size, void* d_ws, size_t ws_size, hipStream_t stream) {
    static int grid = 0;
    if (grid == 0) {
        if (n_in != 20 || out_size != NTOK * DM || ws_size < WS_END) { fprintf(stderr, "kernel_launch: unexpected sizes (n_in %d, out %d, ws %zu)\n", n_in, out_size, ws_size); grid = -1; return; }
        int dev = 0, cus = 0;
        if (hipGetDevice(&dev) != hipSuccess || hipDeviceGetAttribute(&cus, hipDeviceAttributeMultiprocessorCount, dev) != hipSuccess) { grid = -1; return; }
        for (int j = 0; j < 13; ++j) if (hipFuncSetAttribute(kfun(j), hipFuncAttributeMaxDynamicSharedMemorySize, LDS_BYTES) != hipSuccess) { fprintf(stderr, "kernel_launch: hipFuncSetAttribute failed\n"); grid = -1; return; }
        (void)hipGetLastError();
        grid = cus;
    }
    if (grid < 0) return;
    (void)hipMemsetAsync((char*)d_ws + WS_CTL, 0, CTL_ZERO_BYTES, stream);
    Args a{};
    for (int i = 0; i < 20; ++i) a.in[i] = (const float*)d_in[i];
    a.out = (float*)d_out; a.ws = (unsigned char*)d_ws; a.pad = 0;
    if (N_LAUNCH_MODE == 1) {
        a.ph_lo = 0; a.ph_hi = PH_TOTAL; a.use_bar = 1;
        void* av[] = {&a};
        (void)hipLaunchKernel(kfun(12), dim3(grid), dim3(NTHR), av, LDS_BYTES, stream);
    } else {
        for (int p = 0; p < PH_TOTAL; ++p) { a.ph_lo = p; a.ph_hi = p + 1; a.use_bar = 0;
            const int j = (p == 0) ? 10 : (p == PH_TOTAL - 1 ? 11 : (p - 1) % PH_PER_LAYER);
            void* av[] = {&a};
            (void)hipLaunchKernel(kfun(j), dim3(grid), dim3(NTHR), av, LDS_BYTES, stream); }
    }
}
```

```cpp
#include <hip/hip_runtime.h>
#include <cstdio>
#include <cstdint>

#define GAS __attribute__((address_space(1)))
#define LAS __attribute__((address_space(3)))
typedef unsigned short bf16;
typedef unsigned short bf16_t;
typedef short bf16x8 __attribute__((ext_vector_type(8)));
typedef float f32x4 __attribute__((ext_vector_type(4)));
typedef float f32x2 __attribute__((ext_vector_type(2)));
typedef unsigned u32x4 __attribute__((ext_vector_type(4)));
typedef unsigned u32x2 __attribute__((ext_vector_type(2)));
typedef GAS unsigned gu32;

constexpr int DM = 1024, NB = 8, SEQ = 4096, NL = 4, NTOK = NB * SEQ;
constexpr int SBW = 512, SBH = 8, SBD = 64;
constexpr int GH = 4, GDK = 64, GDV = 128, GKW = 256, GVW = 512, GRANK = 16;
constexpr int DIN = 3088, PROJW = 3072;
constexpr int NGRP = 4, EPG = 8, NEXP = 32, DEXP = 256, NMOD = 6;
constexpr float EPS = 1e-6f;
constexpr float LOG2E = 1.4426950408889634f;
constexpr float QSCALE = 0.125f * LOG2E;
constexpr int PC_Q = 0, PC_K = 512, PC_V = 1024, PC_GQ = 1536, PC_GK = 1792, PC_GV = 2048, PC_GR = 2560;
constexpr int MAXSLOT = 73728;

constexpr size_t MiB = 1u << 20;
constexpr size_t WS_CTL = 0, CTL_ZERO_BYTES = 1 * MiB;
constexpr size_t WS_MOD = 1 * MiB;
constexpr size_t WS_WSM = 2 * MiB;
constexpr size_t WS_WIN = 4 * MiB;
constexpr size_t WS_WOUT = 28 * MiB;
constexpr size_t WS_W1 = 36 * MiB;
constexpr size_t WS_W2 = 164 * MiB;
constexpr size_t WS_H = 228 * MiB;
constexpr size_t WS_MIX = 292 * MiB;
constexpr size_t WS_PROJ = 356 * MiB;
constexpr size_t WS_ACT = 356 * MiB;
constexpr size_t WS_Y = 400 * MiB;
constexpr size_t WS_GLR = 548 * MiB;
constexpr size_t WS_LG = 550 * MiB;
constexpr size_t WS_OB = 582 * MiB;
constexpr size_t WS_GVT = 550 * MiB;
constexpr size_t WS_ST = 582 * MiB;
constexpr size_t WS_GB = 228 * MiB;
constexpr size_t WS_STB = 260 * MiB;
constexpr size_t WS_DECAY = 646 * MiB + 512 * 1024;
constexpr size_t WS_TOKE = 646 * MiB;
constexpr size_t WS_TOKP = WS_TOKE + 256 * 1024;
constexpr size_t WS_TOKW = WS_TOKP + 256 * 1024;
constexpr size_t WS_TOKOF = 647 * MiB;
constexpr size_t WS_SLOTW = 651 * MiB;
constexpr size_t WS_END = 655 * MiB;
static_assert(WS_ACT + (size_t)MAXSLOT * DEXP * 2 <= WS_Y && WS_Y + (size_t)MAXSLOT * DM * 2 <= WS_PROJ + (size_t)NTOK * PROJW * 2 && WS_PROJ + (size_t)NTOK * PROJW * 2 <= WS_GLR, "ws map");
constexpr int CW_TMO = 0;
constexpr int CW_BAR = 4096;
constexpr int CW_CNT = 16384;

constexpr int RING_BYTES = 131072;
constexpr int GLA_WL = 17408;
constexpr int LDSCTL_OFF = 8 * GLA_WL, MISC_OFF = LDSCTL_OFF + 320;
constexpr int LDS_BYTES = 147456;

#define RLX_AGENT __ATOMIC_RELAXED, __HIP_MEMORY_SCOPE_AGENT
#define LDS_WAIT() asm volatile("s_waitcnt lgkmcnt(0)" ::: "memory")
#define VM_WAIT() asm volatile("s_waitcnt vmcnt(0)" ::: "memory")
__device__ __forceinline__ unsigned f2bf(float f) { unsigned u = __builtin_bit_cast(unsigned, f); return (u + 0x7fffu + ((u >> 16) & 1u)) >> 16; }
__device__ __forceinline__ unsigned pk2(float lo, float hi) { return f2bf(lo) | (f2bf(hi) << 16); }
__device__ __forceinline__ float bf2f(unsigned short b) { return __builtin_bit_cast(float, (unsigned)b << 16); }
__device__ __forceinline__ float bflo(unsigned w) { return __builtin_bit_cast(float, w << 16); }
__device__ __forceinline__ float bfhi(unsigned w) { return __builtin_bit_cast(float, w & 0xffff0000u); }
__device__ __forceinline__ float siluf(float v) { return v / (1.f + __expf(-v)); }
__device__ __forceinline__ float wave_sum(float v) {
#pragma unroll
    for (int o = 1; o < 64; o <<= 1) v += __shfl_xor(v, o);
    return v;
}

namespace pg8 {
constexpr int BM = 256, BK = 64, HALF = 128, HTB = HALF * BK * 2, NXCD = 8, WGM = 8;
__host__ __device__ __forceinline__ int lds_byte(int r, int c) { const int st = (r >> 4) * 2 + (c >> 5), rr = r & 15, cc = c & 31, ob = rr * 64 + cc * 2; return st * 1024 + (ob ^ (((ob >> 9) & 1) << 5)); }
__host__ __device__ __forceinline__ void stage_rc(int b, int& R, int& C) { const int st = b / 1024, sb = b % 1024, swz = sb ^ (((sb >> 9) & 1) << 5); R = (st >> 1) * 16 + swz / 64; C = (st & 1) * 32 + (swz % 64) / 2; }
__host__ __device__ __forceinline__ int perm32(int rho) { const int n = rho >> 4, i = rho & 15; return 8 * (i >> 2) + 4 * n + (i & 3); }

struct Unit { int pm, pn, pb, aux, nv; };
struct Gemm { const bf16_t* A; const bf16_t* Bt; int K; const int* rowmap; };

struct StaticOrder {
    int nM, nN, nwg, G, c;
    int skip_from, skip_n;
    __device__ void init(int M, int N, int G_, int c_) { nM = M / BM; nN = N / BM; nwg = nM * nN; G = G_; c = c_; skip_from = 1 << 30; skip_n = 0; }
    __device__ bool next(int i, Unit& u) const {
        const long L = (long)i * G + c; if (L >= nwg) return false;
        int wgid = (int)L; { const int q = nwg / NXCD, r = nwg % NXCD, xcd = wgid % NXCD, off = wgid / NXCD; wgid = (xcd < r ? xcd * (q + 1) : r * (q + 1) + (xcd - r) * q) + off; }
        const int nig = WGM * nN, gid = wgid / nig, fm = gid * WGM, gsz = (nM - fm) < WGM ? (nM - fm) : WGM;
        u.pm = fm + ((wgid % nig) % gsz); u.pn = (wgid % nig) / gsz; if (u.pn >= skip_from) u.pn += skip_n; u.pb = u.pn; u.aux = 0; u.nv = BM; return true;
    }
};
struct GroupedOrder {
    const LAS int* tb; int nN, G, c;
    __device__ bool next(int i, Unit& u) const {
        const int L = i * G + c; const int mt = L / nN, ntile = L - mt * nN;
        if (mt >= __builtin_amdgcn_readfirstlane(tb[NEXP])) return false;
        int e = 0, te = 0;
        for (int j = 1; j < NEXP; ++j) { const int tj = __builtin_amdgcn_readfirstlane(tb[j]); if (mt >= tj) { e = j; te = tj; } }
        u.pm = mt; u.pn = ntile; u.pb = e * nN + ntile; u.aux = e * NTOK + (mt - te) * 256;
        u.nv = __builtin_amdgcn_readfirstlane(tb[33 + e]) - (mt - te) * 256;
        return true;
    }
};

__device__ __forceinline__ unsigned cvt_pk_bf16(float lo, float hi) { unsigned r; asm volatile("v_cvt_pk_bf16_f32 %0, %1, %2" : "=v"(r) : "v"(lo), "v"(hi)); return r; }

template <class Epi, class Sched, bool GATHER, bool ALIGN_EPI, bool SP2>
__device__ __forceinline__ void gemm_phase(LAS unsigned char* lds, const Gemm g, const Sched& S, const Epi& E) {
    int tid = threadIdx.x; asm volatile("" : "+v"(tid));
    const int wid = __builtin_amdgcn_readfirstlane(tid >> 6), lane = tid & 63, wr = wid >> 2, wc = wid & 3, fr = lane & 15, fq = lane >> 4;
    int K = g.K; asm volatile("" : "+s"(K)); const int nt = K / BK;
    unsigned voffB[2];
#pragma unroll
    for (int i = 0; i < 2; ++i) { int R, C; stage_rc(tid * 16 + i * 8192, R, C); const int Rb = Epi::PERM ? ((R & ~31) + perm32(R & 31)) : R;
        voffB[i] = (unsigned)(Rb * K + C) * 2u; }
    const size_t kstep = (size_t)(BK * 2);
    const size_t hstep = (size_t)HALF * K * 2;
    const size_t tstep = 2 * hstep;
    const unsigned ldsw = (unsigned)wid * 1024u;
    const int aoff = lds_byte(wr * 64 + fr, fq * 8), boff = lds_byte(wc * 32 + fr, fq * 8);
#define PG8_SA(b, h) (((b) * 2 + (h)) * HTB)
#define PG8_SB(b, h) ((4 + (b) * 2 + (h)) * HTB)
#define PG8_STAGE(bufoff, gbase, voff) do { _Pragma("unroll") for (int _i = 0; _i < 2; ++_i) \
        __builtin_amdgcn_global_load_lds((const unsigned*)((const char*)(gbase) + (voff)[_i]), (LAS unsigned*)(lds + (bufoff) + ldsw + _i * 8192), 16, 0, 0); } while (0)
#define PG8_LDA(dst, b, h) do { _Pragma("unroll") for (int m = 0; m < 4; ++m) _Pragma("unroll") for (int k = 0; k < 2; ++k) dst[m][k] = *(const LAS bf16x8*)(lds + PG8_SA(b, h) + aoff + m * 2048 + k * 1024); } while (0)
#define PG8_LDB(dst, b, h) do { _Pragma("unroll") for (int n = 0; n < 2; ++n) _Pragma("unroll") for (int k = 0; k < 2; ++k) dst[n][k] = *(const LAS bf16x8*)(lds + PG8_SB(b, h) + boff + n * 2048 + k * 1024); } while (0)
#define PG8_MMA(ai, bj, At, Bt) do { __builtin_amdgcn_s_setprio(1); _Pragma("unroll") for (int m = 0; m < 4; ++m) _Pragma("unroll") for (int n = 0; n < 2; ++n) _Pragma("unroll") for (int k = 0; k < 2; ++k) \
        acc[ai][bj][m][n] = __builtin_amdgcn_mfma_f32_16x16x32_bf16(Bt[n][k], At[m][k], acc[ai][bj][m][n], 0, 0, 0); __builtin_amdgcn_s_setprio(0); } while (0)
#define PG8_WAIT_V(n) asm volatile("s_waitcnt vmcnt(" #n ")" ::: "memory")
#define PG8_WAIT_L(n) asm volatile("s_waitcnt lgkmcnt(" #n ")" ::: "memory")
#define PG8_BAR __builtin_amdgcn_s_barrier()
#define PG8_SCHED __builtin_amdgcn_sched_barrier(0)
#define PG8_SETA(V0, V1, u) do { _Pragma("unroll") for (int _i = 0; _i < 2; ++_i) { int r0, r1, Rp_, Cp_; stage_rc(tid * 16 + _i * 8192, Rp_, Cp_); \
        if (GATHER) { r0 = (Rp_ < (u).nv) ? g.rowmap[(u).aux + Rp_] : 0; r1 = (HALF + Rp_ < (u).nv) ? g.rowmap[(u).aux + HALF + Rp_] : 0; } else { r0 = (u).pm * BM + Rp_; r1 = r0 + HALF; } \
        V0[_i] = (unsigned)(r0 * K + Cp_) * 2u; V1[_i] = (unsigned)(r1 * K + Cp_) * 2u; } } while (0)
    Unit cur, nxt; int ui = 0;
    if (!S.next(0, cur)) return;
    f32x4 acc[2][2][4][2];
#pragma unroll
    for (int a = 0; a < 2; ++a)
#pragma unroll
        for (int b = 0; b < 2; ++b)
#pragma unroll
            for (int m = 0; m < 4; ++m)
#pragma unroll
                for (int n = 0; n < 2; ++n) acc[a][b][m][n] = (f32x4){0.f, 0.f, 0.f, 0.f};
    bf16x8 At[4][2], B0[2][2], B1[2][2];
    unsigned cA0[2], cA1[2], nA0[2], nA1[2];
    PG8_SETA(cA0, cA1, cur);
    const char* const gA = (const char*)g.A;
    const char* cB = (const char*)g.Bt + (size_t)cur.pb * tstep;
    if constexpr (SP2) {
        PG8_STAGE(PG8_SB(0, 0), cB, voffB); PG8_STAGE(PG8_SB(0, 1), cB + hstep, voffB); PG8_STAGE(PG8_SA(0, 0), gA, cA0); PG8_STAGE(PG8_SA(0, 1), gA, cA1);
        if (wr == 1) PG8_BAR;
        PG8_WAIT_V(2); PG8_BAR;
        PG8_STAGE(PG8_SB(1, 0), cB + kstep, voffB); PG8_STAGE(PG8_SA(1, 0), gA + kstep, cA0); PG8_STAGE(PG8_SB(1, 1), cB + hstep + kstep, voffB);
        PG8_WAIT_V(6); PG8_BAR;
    } else {
        PG8_STAGE(PG8_SB(0, 0), cB, voffB); PG8_STAGE(PG8_SA(0, 0), gA, cA0); PG8_STAGE(PG8_SB(0, 1), cB + hstep, voffB); PG8_STAGE(PG8_SA(0, 1), gA, cA1);
        if (wr == 1) PG8_BAR;
        PG8_WAIT_V(4); PG8_BAR;
        PG8_STAGE(PG8_SB(1, 0), cB + kstep, voffB); PG8_STAGE(PG8_SA(1, 0), gA + kstep, cA0); PG8_STAGE(PG8_SB(1, 1), cB + hstep + kstep, voffB);
        PG8_WAIT_V(6); PG8_BAR;
    }
    for (;;) {
        const bool has_next = S.next(ui + 1, nxt);
        if (has_next) { PG8_SETA(nA0, nA1, nxt); } else {
#pragma unroll
            for (int _i = 0; _i < 2; ++_i) { nA0[_i] = cA0[_i]; nA1[_i] = cA1[_i]; } }
        const char* nB = has_next ? (const char*)g.Bt + (size_t)nxt.pb * tstep : cB;
#pragma unroll 1
        for (int t = 0; t < nt; t += 2) {
            const bool last = (t == nt - 2);
            const char* a1 = gA + (size_t)(t + 1) * kstep;
            const char* a2 = last ? gA : gA + (size_t)(t + 2) * kstep; const char* b2 = last ? nB : cB + (size_t)(t + 2) * kstep;
            const char* a3 = a2 + kstep; const char* b3 = b2 + kstep;
            unsigned xA0[2], xA1[2];
#pragma unroll
            for (int _i = 0; _i < 2; ++_i) { xA0[_i] = last ? nA0[_i] : cA0[_i]; xA1[_i] = last ? nA1[_i] : cA1[_i]; }
            if constexpr (SP2) {
            PG8_LDB(B0, 0, 0); PG8_LDB(B1, 0, 1); PG8_SCHED; PG8_LDA(At, 0, 0); PG8_STAGE(PG8_SA(1, 1), a1, cA1);
            PG8_WAIT_V(8); PG8_WAIT_L(0); PG8_BAR; PG8_MMA(0, 0, At, B0); PG8_MMA(0, 1, At, B1); PG8_BAR; PG8_SCHED;
            PG8_LDA(At, 0, 1); PG8_STAGE(PG8_SB(0, 0), b2, voffB); PG8_STAGE(PG8_SB(0, 1), b2 + hstep, voffB); PG8_STAGE(PG8_SA(0, 0), a2, xA0);
            PG8_WAIT_V(8); PG8_WAIT_L(0); PG8_BAR; PG8_MMA(1, 0, At, B0); PG8_MMA(1, 1, At, B1); PG8_BAR; PG8_SCHED;
            PG8_LDB(B0, 1, 0); PG8_LDB(B1, 1, 1); PG8_SCHED; PG8_LDA(At, 1, 0); PG8_STAGE(PG8_SA(0, 1), a2, xA1);
            PG8_WAIT_V(8); PG8_WAIT_L(0); PG8_BAR; PG8_MMA(0, 0, At, B0); PG8_MMA(0, 1, At, B1); PG8_BAR; PG8_SCHED;
            PG8_LDA(At, 1, 1); PG8_STAGE(PG8_SB(1, 0), b3, voffB); PG8_STAGE(PG8_SB(1, 1), b3 + hstep, voffB); PG8_STAGE(PG8_SA(1, 0), a3, xA0);
            PG8_WAIT_V(8); PG8_WAIT_L(0); PG8_BAR; PG8_MMA(1, 0, At, B0); PG8_MMA(1, 1, At, B1); PG8_BAR; PG8_SCHED;
            } else {
            PG8_LDB(B0, 0, 0); PG8_SCHED; PG8_LDA(At, 0, 0); PG8_STAGE(PG8_SA(1, 1), a1, cA1);
            PG8_WAIT_L(8); PG8_BAR; PG8_WAIT_L(0); PG8_MMA(0, 0, At, B0); PG8_BAR; PG8_SCHED;
            PG8_LDB(B1, 0, 1); PG8_STAGE(PG8_SB(0, 0), b2, voffB);
            PG8_BAR; PG8_WAIT_L(0); PG8_MMA(0, 1, At, B1); PG8_BAR;
            PG8_LDA(At, 0, 1); PG8_STAGE(PG8_SA(0, 0), a2, xA0);
            PG8_BAR; PG8_WAIT_L(0); PG8_MMA(1, 0, At, B0); PG8_BAR; PG8_SCHED;
            PG8_STAGE(PG8_SB(0, 1), b2 + hstep, voffB);
            PG8_WAIT_V(6); PG8_BAR; PG8_MMA(1, 1, At, B1); PG8_BAR;
            PG8_LDB(B0, 1, 0); PG8_SCHED; PG8_LDA(At, 1, 0); PG8_STAGE(PG8_SA(0, 1), a2, xA1);
            PG8_WAIT_L(8); PG8_BAR; PG8_WAIT_L(0); PG8_MMA(0, 0, At, B0); PG8_BAR; PG8_SCHED;
            PG8_LDB(B1, 1, 1); PG8_STAGE(PG8_SB(1, 0), b3, voffB);
            PG8_BAR; PG8_WAIT_L(0); PG8_MMA(0, 1, At, B1); PG8_BAR;
            PG8_LDA(At, 1, 1); PG8_STAGE(PG8_SA(1, 0), a3, xA0);
            PG8_BAR; PG8_WAIT_L(0); PG8_MMA(1, 0, At, B0); PG8_BAR; PG8_SCHED;
            PG8_STAGE(PG8_SB(1, 1), b3 + hstep, voffB);
            PG8_WAIT_V(6); PG8_BAR; PG8_MMA(1, 1, At, B1); PG8_BAR;
            }
        }
        if constexpr (ALIGN_EPI) { if (wr == 0) PG8_BAR; }
        E(acc, cur, wr, wc, fr, fq);
        if (!has_next) break;
#pragma unroll
        for (int a = 0; a < 2; ++a)
#pragma unroll
            for (int b = 0; b < 2; ++b)
#pragma unroll
                for (int m = 0; m < 4; ++m)
#pragma unroll
                    for (int n = 0; n < 2; ++n) acc[a][b][m][n] = (f32x4){0.f, 0.f, 0.f, 0.f};
        cur = nxt; cB = nB; ++ui;
#pragma unroll
        for (int _i = 0; _i < 2; ++_i) { cA0[_i] = nA0[_i]; cA1[_i] = nA1[_i]; }
        if constexpr (ALIGN_EPI) { if (wr == 1) PG8_BAR; }
    }
    PG8_WAIT_V(0);
    if constexpr (!ALIGN_EPI) { if (wr == 0) PG8_BAR; }
    PG8_BAR;
#undef PG8_SA
#undef PG8_SB
#undef PG8_STAGE
#undef PG8_LDA
#undef PG8_LDB
#undef PG8_MMA
#undef PG8_WAIT_V
#undef PG8_WAIT_L
#undef PG8_BAR
#undef PG8_SCHED
#undef PG8_SETA
}

struct EpiProj {
    static constexpr bool PERM = true;
    bf16_t* P; const float* qgain; const float* kgain;
    __device__ __forceinline__ void operator()(const f32x4 (&acc)[2][2][4][2], const Unit& u, int wr, int wc, int fr, int fq) const {
        asm volatile("" : "+v"(fr), "+v"(fq));
        const int row0 = u.pm * BM + wr * 64 + fr; const int pn = u.pn;
        if (pn < 4) {
            const float* gain = (pn < 2) ? qgain : kgain; const float sc = (pn < 2) ? QSCALE : 1.f;
            f32x4 gv[2][2];
#pragma unroll
            for (int bj = 0; bj < 2; ++bj)
#pragma unroll
                for (int n = 0; n < 2; ++n) gv[bj][n] = *(const f32x4*)(gain + 32 * bj + 8 * fq + 4 * n) * sc;
            const int col0 = 256 * pn + 64 * wc + 8 * fq;
#pragma unroll
            for (int ai = 0; ai < 2; ++ai)
#pragma unroll
                for (int m = 0; m < 4; ++m) {
                    float ss = 0.f;
#pragma unroll
                    for (int bj = 0; bj < 2; ++bj)
#pragma unroll
                        for (int n = 0; n < 2; ++n) { const f32x4 x = acc[ai][bj][m][n]; ss += (x[0] * x[0] + x[1] * x[1]) + (x[2] * x[2] + x[3] * x[3]); }
                    ss += __shfl_xor(ss, 16); ss += __shfl_xor(ss, 32);
                    const float rstd = __builtin_amdgcn_rsqf(ss * (1.f / 64.f) + EPS);
                    bf16_t* rowp = P + (size_t)(row0 + ai * HALF + m * 16) * PROJW + col0;
#pragma unroll
                    for (int bj = 0; bj < 2; ++bj) { const f32x4 v0 = acc[ai][bj][m][0] * rstd * gv[bj][0], v1 = acc[ai][bj][m][1] * rstd * gv[bj][1];
                        u32x4 w; w.x = cvt_pk_bf16(v0[0], v0[1]); w.y = cvt_pk_bf16(v0[2], v0[3]); w.z = cvt_pk_bf16(v1[0], v1[1]); w.w = cvt_pk_bf16(v1[2], v1[3]);
                        *(u32x4*)(rowp + bj * 32) = w; }
                }
        } else {
            const float sc = (pn == 6) ? 0.125f : 1.f; const bool act = (pn >= 10);
            const int col0 = 256 * pn + 32 * wc + 8 * fq;
#pragma unroll
            for (int ai = 0; ai < 2; ++ai)
#pragma unroll
                for (int m = 0; m < 4; ++m) { bf16_t* rowp = P + (size_t)(row0 + ai * HALF + m * 16) * PROJW + col0;
#pragma unroll
                    for (int bj = 0; bj < 2; ++bj) { f32x4 v0 = acc[ai][bj][m][0] * sc, v1 = acc[ai][bj][m][1] * sc;
                        if (act) {
#pragma unroll
                            for (int j = 0; j < 4; ++j) { v0[j] = siluf(v0[j]); v1[j] = siluf(v1[j]); } }
                        u32x4 w; w.x = cvt_pk_bf16(v0[0], v0[1]); w.y = cvt_pk_bf16(v0[2], v0[3]); w.z = cvt_pk_bf16(v1[0], v1[1]); w.w = cvt_pk_bf16(v1[2], v1[3]);
                        *(u32x4*)(rowp + bj * HALF) = w; } }
        }
    }
};
struct EpiResid {
    static constexpr bool PERM = true;
    const float* xin; float* X; const float* gate;
    __device__ __forceinline__ void operator()(const f32x4 (&acc)[2][2][4][2], const Unit& u, int wr, int wc, int fr, int fq) const {
        asm volatile("" : "+v"(fr), "+v"(fq));
        const int row0 = u.pm * BM + wr * 64 + fr; const int b = (u.pm * BM) / SEQ;
        const int col0 = u.pn * BM + wc * 32 + 8 * fq; const float* gp = gate + (size_t)b * (NMOD * DM);
        f32x4 gv[2][2];
#pragma unroll
        for (int bj = 0; bj < 2; ++bj)
#pragma unroll
            for (int n = 0; n < 2; ++n) gv[bj][n] = *(const f32x4*)(gp + col0 + bj * HALF + 4 * n);
#pragma unroll
        for (int ai = 0; ai < 2; ++ai)
#pragma unroll
            for (int mp = 0; mp < 2; ++mp) {
                f32x4 xi[2][2][2];
#pragma unroll
                for (int mm = 0; mm < 2; ++mm) { const size_t ro = (size_t)(row0 + ai * HALF + (2 * mp + mm) * 16) * DM + col0;
#pragma unroll
                    for (int bj = 0; bj < 2; ++bj)
#pragma unroll
                        for (int n = 0; n < 2; ++n) xi[mm][bj][n] = *(const f32x4*)(xin + ro + bj * HALF + 4 * n); }
#pragma unroll
                for (int mm = 0; mm < 2; ++mm) { const size_t ro = (size_t)(row0 + ai * HALF + (2 * mp + mm) * 16) * DM + col0;
#pragma unroll
                    for (int bj = 0; bj < 2; ++bj)
#pragma unroll
                        for (int n = 0; n < 2; ++n) *(f32x4*)(X + ro + bj * HALF + 4 * n) = xi[mm][bj][n] + gv[bj][n] * acc[ai][bj][2 * mp + mm][n]; }
                asm volatile("" ::: "memory"); }
    }
};
struct EpiMoeAct {
    static constexpr bool PERM = true;
    bf16_t* ACT; const float* slotw;
    __device__ __forceinline__ void operator()(const f32x4 (&acc)[2][2][4][2], const Unit& u, int wr, int wc, int fr, int fq) const {
        asm volatile("" : "+v"(fr), "+v"(fq));
        const int rl = wr * 64 + fr; const int col0 = 128 * u.pn + 32 * wc + 8 * fq;
#pragma unroll
        for (int ai = 0; ai < 2; ++ai)
#pragma unroll
            for (int m = 0; m < 4; ++m) { const int r = rl + ai * HALF + m * 16; const float w = (r < u.nv) ? slotw[u.aux + r] : 0.f;
                f32x4 g0 = acc[ai][0][m][0], g1 = acc[ai][0][m][1]; const f32x4 u0 = acc[ai][1][m][0], u1 = acc[ai][1][m][1];
#pragma unroll
                for (int j = 0; j < 4; ++j) { g0[j] = siluf(g0[j]) * u0[j] * w; g1[j] = siluf(g1[j]) * u1[j] * w; }
                u32x4 o; o.x = cvt_pk_bf16(g0[0], g0[1]); o.y = cvt_pk_bf16(g0[2], g0[3]); o.z = cvt_pk_bf16(g1[0], g1[1]); o.w = cvt_pk_bf16(g1[2], g1[3]);
                *(u32x4*)(ACT + (size_t)(u.pm * BM + r) * DEXP + col0) = o; }
    }
};
struct EpiStore {
    static constexpr bool PERM = true;
    bf16_t* O; int ldc;
    __device__ __forceinline__ void operator()(const f32x4 (&acc)[2][2][4][2], const Unit& u, int wr, int wc, int fr, int fq) const {
        asm volatile("" : "+v"(fr), "+v"(fq));
        const int row0 = u.pm * BM + wr * 64 + fr; const int col0 = u.pn * BM + wc * 32 + 8 * fq;
#pragma unroll
        for (int ai = 0; ai < 2; ++ai)
#pragma unroll
            for (int m = 0; m < 4; ++m) { bf16_t* rowp = O + (size_t)(row0 + ai * HALF + m * 16) * ldc + col0;
#pragma unroll
                for (int bj = 0; bj < 2; ++bj) { const f32x4 v0 = acc[ai][bj][m][0], v1 = acc[ai][bj][m][1];
                    u32x4 w; w.x = cvt_pk_bf16(v0[0], v0[1]); w.y = cvt_pk_bf16(v0[2], v0[3]); w.z = cvt_pk_bf16(v1[0], v1[1]); w.w = cvt_pk_bf16(v1[2], v1[3]);
                    *(u32x4*)(rowp + bj * HALF) = w; } }
    }
};
}

#define XB_TMO      128
#define XB_XCNT(j)  (256  + 64 * (j))
#define XB_XSUB(j)  (1280 + 64 * (j))
#define XB_XGEN(j)  (2304 + 64 * (j))
#define XB_TOP      3328
#define XB_TOPGEN   3392
#define XCD_BAR_WORDS 3456
#define XB_SPIN_CAP (1u << 18)
__device__ __forceinline__ unsigned xb_ld(unsigned* p)              { return __hip_atomic_load(p, __ATOMIC_RELAXED, __HIP_MEMORY_SCOPE_AGENT); }
__device__ __forceinline__ unsigned xb_add(unsigned* p, unsigned v) { return __hip_atomic_fetch_add(p, v, __ATOMIC_RELAXED, __HIP_MEMORY_SCOPE_AGENT); }
__device__ __forceinline__ unsigned xb_xcc_id() { return (unsigned)__builtin_amdgcn_s_getreg((3 << 11) | 20) & 0xFu; }
#define XB_SPIN(cond, bar) do { unsigned _sp = 0; while (cond) { __builtin_amdgcn_s_sleep(1); \
    if ((++_sp & 255u) == 0u) { if (xb_ld(&(bar)[XB_TMO])) break; if (_sp > XB_SPIN_CAP) { atomicAdd(&(bar)[XB_TMO], 1u); break; } } } } while (0)
struct XcdBarrier { unsigned* bar; unsigned x; volatile LAS unsigned* st; };
__device__ __forceinline__ XcdBarrier xcd_barrier_post(unsigned* bar, volatile LAS unsigned* st) {
    XcdBarrier b; b.bar = bar; b.x = xb_xcc_id(); b.st = st;
    if (threadIdx.x == 0) (void)xb_add(&bar[XB_XCNT(b.x)], 1u);
    return b;
}
__device__ __forceinline__ void xcd_barrier_complete(unsigned* bar, unsigned x, unsigned& nloc, unsigned& nx) {
    const unsigned G = gridDim.x * gridDim.y * gridDim.z;
    unsigned sum, cnt, mine, sp = 0u;
    for (;;) {
        sum = 0u; cnt = 0u; mine = 0u;
#pragma unroll
        for (unsigned j = 0; j < 16; ++j) { const unsigned c = xb_ld(&bar[XB_XCNT(j)]); sum += c; cnt += (c > 0u) ? 1u : 0u; mine = (j == x) ? c : mine; }
        if (sum == G) break;
        __builtin_amdgcn_s_sleep(1);
        if ((++sp & 255u) == 0u) { if (xb_ld(&bar[XB_TMO])) break; if (sp > XB_SPIN_CAP) { atomicAdd(&bar[XB_TMO], 1u); break; } }
    }
    nloc = mine > 0u ? mine : 1u; nx = cnt > 0u ? cnt : 1u;
}
__device__ __forceinline__ void xcd_barrier(const XcdBarrier& b) {
    asm volatile("s_waitcnt vmcnt(0)" ::: "memory");
    __syncthreads();
    if (threadIdx.x == 0) {
        unsigned* bar = b.bar;
        __builtin_amdgcn_s_waitcnt(0);
        unsigned nloc = b.st[0], nx = b.st[1];
        if (nloc == 0u) { xcd_barrier_complete(bar, b.x, nloc, nx); b.st[0] = nloc; b.st[1] = nx; }
        const unsigned old = xb_add(&bar[XB_XSUB(b.x)], 1u);
        const unsigned gen = old / nloc;
        if (old + 1u == (gen + 1u) * nloc) {
            __builtin_amdgcn_fence(__ATOMIC_RELEASE, "agent");
            asm volatile("s_waitcnt vmcnt(0)" ::: "memory");
            const unsigned og = xb_add(&bar[XB_TOP], 1u);
            const unsigned tg = og / nx;
            if (og + 1u == (tg + 1u) * nx) xb_add(&bar[XB_TOPGEN], 1u);
            else XB_SPIN(xb_ld(&bar[XB_TOPGEN]) == tg, bar);
            __builtin_amdgcn_fence(__ATOMIC_ACQUIRE, "agent");
            xb_add(&bar[XB_XGEN(b.x)], 1u);
            asm volatile("s_waitcnt vmcnt(0)" ::: "memory");
        } else {
            XB_SPIN(xb_ld(&bar[XB_XGEN(b.x)]) == gen, bar);
            __builtin_amdgcn_fence(__ATOMIC_ACQUIRE, "agent");
            asm volatile("s_waitcnt vmcnt(0)" ::: "memory");
        }
    }
    __syncthreads();
}

constexpr int NWAVES = 8, NTHR = 512;
struct Frame {
    LAS unsigned char* lds;
    volatile LAS unsigned* MISC;
    unsigned* ctl;
    int tid, lane, wave, vcu, G;
    float* out; unsigned char* ws;
};
constexpr int PTAB_OFF = LDSCTL_OFF + 512;
__device__ __forceinline__ const float* inptr(const Frame& F, int i) {
    const LAS unsigned* p = (const LAS unsigned*)(F.lds + PTAB_OFF) + 2 * i;
    const unsigned lo = __builtin_amdgcn_readfirstlane(p[0]), hi = __builtin_amdgcn_readfirstlane(p[1]);
    return (const float*)(((unsigned long long)hi << 32) | lo);
}
#define F_X (inptr(F, 0))
#define F_C (inptr(F, 1))
#define F_WADA (inptr(F, 2))
#define F_BADA (inptr(F, 3))
#define F_NMIX (inptr(F, 4))
#define F_NFFN (inptr(F, 5))
#define F_WIN (inptr(F, 6))
#define F_WGK2 (inptr(F, 7))
#define F_BGK (inptr(F, 8))
#define F_QGAIN (inptr(F, 9))
#define F_KGAIN (inptr(F, 10))
#define F_GLAGAIN (inptr(F, 11))
#define F_WOUT (inptr(F, 12))
#define F_WRG (inptr(F, 13))
#define F_BRG (inptr(F, 14))
#define F_WRE (inptr(F, 15))
#define F_BRE (inptr(F, 16))
#define F_WGATE (inptr(F, 17))
#define F_WUP (inptr(F, 18))
#define F_WDOWN (inptr(F, 19))

#define PHASE_FRAME(F0) Frame F; { unsigned char* ws_ = (F0).ws; float* out_ = (F0).out; int tid_ = threadIdx.x, g_ = (F0).G, vcu_ = (F0).vcu; \
    asm volatile("" : "+s"(ws_), "+s"(out_), "+v"(tid_), "+s"(g_), "+s"(vcu_)); \
    F.lds = (F0).lds; F.MISC = (F0).MISC; F.ws = ws_; F.out = out_; F.ctl = (unsigned*)ws_; F.tid = tid_; F.lane = tid_ & 63; F.wave = __builtin_amdgcn_readfirstlane(tid_ >> 6); F.G = g_; F.vcu = vcu_; }

__device__ __forceinline__ void p0_transpose_item(const float* W, int K, int N, bf16* WT, int k0, int n0, int drow0, LAS float* scr, int lane) {
    f32x4 v[8];
#pragma unroll
    for (int i = 0; i < 8; ++i) v[i] = *(const f32x4*)(W + (size_t)(k0 + 8 * i + (lane >> 3)) * N + n0 + (lane & 7) * 4);
#pragma unroll
    for (int i = 0; i < 8; ++i) { LAS float* d = scr + (8 * i + (lane >> 3)) * 33 + (lane & 7) * 4; d[0] = v[i][0]; d[1] = v[i][1]; d[2] = v[i][2]; d[3] = v[i][3]; }
    LDS_WAIT(); asm volatile("" ::: "memory");
    const int c = lane & 7;
#pragma unroll
    for (int j = 0; j < 4; ++j) { const int n = (lane >> 3) + 8 * j; const LAS float* s = scr + (8 * c) * 33 + n;
        u32x4 o; o.x = pk2(s[0 * 33], s[1 * 33]); o.y = pk2(s[2 * 33], s[3 * 33]); o.z = pk2(s[4 * 33], s[5 * 33]); o.w = pk2(s[6 * 33], s[7 * 33]);
        *(u32x4*)(WT + (size_t)(drow0 + n) * K + k0 + 8 * c) = o; }
    LDS_WAIT(); asm volatile("" ::: "memory");
}
__device__ __forceinline__ void p0_prologue(Frame& F0) {
    PHASE_FRAME(F0);
    LAS float* scr = (LAS float*)(F.lds + F.wave * 16384);
    const int gw = F.vcu * NWAVES + F.wave, NGW = F.G * NWAVES, lane = F.lane;
    constexpr int I_IN = 16 * 96, I_OUT = 16 * 32, I_G = NEXP * 16 * 8, I_D = NEXP * 4 * 32, I_LAYER = I_IN + I_OUT + 2 * I_G + I_D;
    for (int it = gw; it < NL * I_LAYER; it += NGW) {
        const int l = it / I_LAYER; int r = it - l * I_LAYER;
        if (r < I_IN) {
            const int kb = r / 96, nb = r % 96, n0 = nb * 32; int drow0 = n0;
            if (n0 < 1024) { const int sec = n0 >> 9, f = n0 & 511, head = f >> 6, bjp = (f >> 5) & 1; drow0 = sec * 512 + 256 * (head >> 2) + 128 * bjp + 32 * (head & 3); }
            p0_transpose_item(F_WIN + (size_t)l * DM * DIN, DM, DIN, (bf16*)(F.ws + WS_WIN) + (size_t)l * PROJW * DM, kb * 64, n0, drow0, scr, lane); continue; }
        r -= I_IN;
        if (r < I_OUT) { const int kb = r / 32, nb = r % 32;
            p0_transpose_item(F_WOUT + (size_t)l * DM * DM, DM, DM, (bf16*)(F.ws + WS_WOUT) + (size_t)l * DM * DM, kb * 64, nb * 32, nb * 32, scr, lane); continue; }
        r -= I_OUT;
        if (r < 2 * I_G) { const int up = r / I_G; r -= up * I_G; const int e = r / 128, q = r % 128, kb = q / 8, nb = q % 8, n0 = nb * 32;
            const float* W = (up ? F_WUP : F_WGATE) + ((size_t)l * NEXP + e) * DM * DEXP;
            bf16* WT = (bf16*)(F.ws + WS_W1) + ((size_t)l * NEXP + e) * 512 * DM;
            p0_transpose_item(W, DM, DEXP, WT, kb * 64, n0, 256 * (n0 >> 7) + 128 * up + (n0 & 127), scr, lane); continue; }
        r -= 2 * I_G;
        { const int e = r / 128, q = r % 128, kb = q / 32, nb = q % 32;
            p0_transpose_item(F_WDOWN + ((size_t)l * NEXP + e) * DEXP * DM, DEXP, DM, (bf16*)(F.ws + WS_W2) + ((size_t)l * NEXP + e) * DM * DEXP, kb * 64, nb * 32, nb * 32, scr, lane); }
    }
    for (int idx = F.vcu * NTHR + F.tid; idx < NL * 64 * DM; idx += F.G * NTHR) {
        const int k = idx & (DM - 1), n = (idx >> 10) & 63, l = idx >> 16; float v = 0.f;
        if (n < 16) v = F_WIN[((size_t)l * DM + k) * DIN + PROJW + n];
        else if (n < 20) v = F_WRG[((size_t)l * DM + k) * NGRP + (n - 16)];
        else if (n < 52) v = F_WRE[((size_t)l * DM + k) * NEXP + (n - 20)];
        ((_Float16*)(F.ws + WS_WSM))[idx] = (_Float16)v;
    }
    __syncthreads();
    {   LAS float* cact = (LAS float*)F.lds; LAS float* part = (LAS float*)(F.lds + 32768);
        for (int i = F.tid; i < NB * DM; i += NTHR) cact[i] = siluf(F_C[i]);
        __syncthreads();
        float* mod = (float*)(F.ws + WS_MOD);
        for (int task = F.vcu; task < NL * NMOD * DM / 64; task += F.G) {
            const int l = task / (NMOD * DM / 64), jb = task - l * (NMOD * DM / 64), j = jb * 64 + lane, k0 = 128 * F.wave;
            const float* w = F_WADA + ((size_t)l * DM + k0) * NMOD * DM + j;
            float a[NB];
#pragma unroll
            for (int b = 0; b < NB; ++b) a[b] = 0.f;
#pragma unroll 4
            for (int kk = 0; kk < 128; kk += 4) { float wv[4];
#pragma unroll
                for (int i = 0; i < 4; ++i) wv[i] = w[(size_t)(kk + i) * NMOD * DM];
#pragma unroll
                for (int b = 0; b < NB; ++b) { const f32x4 cv = *(const LAS f32x4*)(cact + b * DM + k0 + kk); a[b] += cv[0] * wv[0] + cv[1] * wv[1] + cv[2] * wv[2] + cv[3] * wv[3]; } }
#pragma unroll
            for (int b = 0; b < NB; ++b) part[(F.wave * NB + b) * 64 + lane] = a[b];
            __syncthreads();
            { const int b = F.tid >> 6, col = F.tid & 63; float sum = F_BADA[l * NMOD * DM + jb * 64 + col];
#pragma unroll
              for (int ww = 0; ww < NWAVES; ++ww) sum += part[(ww * NB + b) * 64 + col];
              mod[((size_t)l * NB + b) * NMOD * DM + jb * 64 + col] = sum; }
            __syncthreads();
        }
    }
}

__device__ __forceinline__ void tile_bases(Frame& F, int l) {
    LAS int* tb = (LAS int*)(F.lds + LDSCTL_OFF);
    __syncthreads();
    if (F.tid == 0) { int s = 0; for (int e = 0; e < NEXP; ++e) { const int c = (int)F.ctl[CW_CNT + l * 64 + e]; tb[e] = s; tb[33 + e] = c; s += (c + 255) >> 8; } tb[NEXP] = s; }
    __syncthreads();
}

__device__ __forceinline__ void phase_norm_a(Frame& F0, int l) {
    PHASE_FRAME(F0);
    const int gw = F.vcu * NWAVES + F.wave, NGW = F.G * NWAVES, lane = F.lane;
    const float* mod = (const float*)(F.ws + WS_MOD);
    if (l > 0) tile_bases(F, l - 1);
    const LAS int* tb = (const LAS int*)(F.lds + LDSCTL_OFF);
    const int* toke = (const int*)(F.ws + WS_TOKE); const int* tokp = (const int*)(F.ws + WS_TOKP);
    const bf16* Y = (const bf16*)(F.ws + WS_Y);
    bf16* H = (bf16*)(F.ws + WS_H); float* GLR = (float*)(F.ws + WS_GLR);
    for (int t = gw; t < NTOK; t += NGW) {
        const int b = t / SEQ;
        f32x4 v[4];
        const float* xr = (l == 0 ? F_X : F.out) + (size_t)t * DM;
#pragma unroll
        for (int j = 0; j < 4; ++j) v[j] = *(const f32x4*)(xr + 4 * lane + 256 * j);
        if (l > 0) {
            const float* gf = mod + ((size_t)(l - 1) * NB + b) * NMOD * DM + 5 * DM;
            const int e0 = toke[2 * t], e1 = toke[2 * t + 1];
            const size_t s0 = (size_t)tb[e0] * 256 + tokp[2 * t], s1 = (size_t)tb[e1] * 256 + tokp[2 * t + 1];
#pragma unroll
            for (int j = 0; j < 4; ++j) { const int c = 4 * lane + 256 * j;
                const u32x2 y0 = *(const u32x2*)(Y + s0 * DM + c), y1 = *(const u32x2*)(Y + s1 * DM + c); const f32x4 g = *(const f32x4*)(gf + c);
                v[j][0] += g[0] * (bflo(y0.x) + bflo(y1.x)); v[j][1] += g[1] * (bfhi(y0.x) + bfhi(y1.x));
                v[j][2] += g[2] * (bflo(y0.y) + bflo(y1.y)); v[j][3] += g[3] * (bfhi(y0.y) + bfhi(y1.y));
                *(f32x4*)(F.out + (size_t)t * DM + c) = v[j]; }
        }
        if (l == NL) continue;
        float ss = 0.f;
#pragma unroll
        for (int j = 0; j < 4; ++j) ss += (v[j][0] * v[j][0] + v[j][1] * v[j][1]) + (v[j][2] * v[j][2] + v[j][3] * v[j][3]);
        const float rstd = 1.f / sqrtf(wave_sum(ss) * (1.f / DM) + EPS);
        const float* mrow = mod + ((size_t)l * NB + b) * NMOD * DM;
        float glr[GRANK];
#pragma unroll
        for (int r = 0; r < GRANK; ++r) glr[r] = 0.f;
#pragma unroll
        for (int j = 0; j < 4; ++j) { const int c = 4 * lane + 256 * j;
            const f32x4 gn = *(const f32x4*)(F_NMIX + l * DM + c), sh = *(const f32x4*)(mrow + c), sc = *(const f32x4*)(mrow + DM + c);
            f32x4 h;
#pragma unroll
            for (int i = 0; i < 4; ++i) h[i] = v[j][i] * rstd * gn[i] * (1.f + sc[i]) + sh[i];
            u32x2 o; o.x = pk2(h[0], h[1]); o.y = pk2(h[2], h[3]);
            *(u32x2*)(H + (size_t)t * DM + c) = o;
#pragma unroll
            for (int i = 0; i < 4; ++i) { const float* wl = F_WIN + ((size_t)l * DM + c + i) * DIN + PROJW;
#pragma unroll
                for (int r4 = 0; r4 < 4; ++r4) { const f32x4 w = *(const f32x4*)(wl + 4 * r4);
                    glr[4 * r4] += h[i] * w[0]; glr[4 * r4 + 1] += h[i] * w[1]; glr[4 * r4 + 2] += h[i] * w[2]; glr[4 * r4 + 3] += h[i] * w[3]; } }
        }
#pragma unroll
        for (int r = 0; r < GRANK; ++r) glr[r] = wave_sum(glr[r]);
        if (lane == 0) {
#pragma unroll
            for (int r4 = 0; r4 < 4; ++r4) *(f32x4*)(GLR + (size_t)t * GRANK + 4 * r4) = (f32x4){glr[4 * r4], glr[4 * r4 + 1], glr[4 * r4 + 2], glr[4 * r4 + 3]};
        }
    }
}

__device__ __forceinline__ void phase_norm_e(Frame& F0, int l) {
    PHASE_FRAME(F0);
    const int gw = F.vcu * NWAVES + F.wave, NGW = F.G * NWAVES, lane = F.lane;
    const float* mod = (const float*)(F.ws + WS_MOD);
    int* toke = (int*)(F.ws + WS_TOKE); int* tokp = (int*)(F.ws + WS_TOKP);
    int* tokof = (int*)(F.ws + WS_TOKOF); float* slotw = (float*)(F.ws + WS_SLOTW);
    bf16* H = (bf16*)(F.ws + WS_H);
    unsigned* cnt = F.ctl + CW_CNT + l * 64;
    for (int t = gw; t < NTOK; t += NGW) {
        const int b = t / SEQ;
        f32x4 v[4];
        const float* xr = F.out + (size_t)t * DM;
#pragma unroll
        for (int j = 0; j < 4; ++j) v[j] = *(const f32x4*)(xr + 4 * lane + 256 * j);
        float ss = 0.f;
#pragma unroll
        for (int j = 0; j < 4; ++j) ss += (v[j][0] * v[j][0] + v[j][1] * v[j][1]) + (v[j][2] * v[j][2] + v[j][3] * v[j][3]);
        const float rstd = 1.f / sqrtf(wave_sum(ss) * (1.f / DM) + EPS);
        const float* mrow = mod + ((size_t)l * NB + b) * NMOD * DM;
        float lg[36];
#pragma unroll
        for (int r = 0; r < 36; ++r) lg[r] = 0.f;
#pragma unroll
        for (int j = 0; j < 4; ++j) { const int c = 4 * lane + 256 * j;
            const f32x4 gn = *(const f32x4*)(F_NFFN + l * DM + c), sh = *(const f32x4*)(mrow + 3 * DM + c), sc = *(const f32x4*)(mrow + 4 * DM + c);
            f32x4 h;
#pragma unroll
            for (int i = 0; i < 4; ++i) h[i] = v[j][i] * rstd * gn[i] * (1.f + sc[i]) + sh[i];
            u32x2 o; o.x = pk2(h[0], h[1]); o.y = pk2(h[2], h[3]);
            *(u32x2*)(H + (size_t)t * DM + c) = o;
#pragma unroll
            for (int i = 0; i < 4; ++i) {
                const f32x4 wg = *(const f32x4*)(F_WRG + ((size_t)l * DM + c + i) * NGRP);
                lg[0] += h[i] * wg[0]; lg[1] += h[i] * wg[1]; lg[2] += h[i] * wg[2]; lg[3] += h[i] * wg[3];
                const float* we = F_WRE + ((size_t)l * DM + c + i) * NEXP;
#pragma unroll
                for (int r4 = 0; r4 < 8; ++r4) { const f32x4 w = *(const f32x4*)(we + 4 * r4);
                    lg[4 + 4 * r4] += h[i] * w[0]; lg[5 + 4 * r4] += h[i] * w[1]; lg[6 + 4 * r4] += h[i] * w[2]; lg[7 + 4 * r4] += h[i] * w[3]; } }
        }
#pragma unroll
        for (int r = 0; r < 36; ++r) lg[r] = wave_sum(lg[r]);
        if (lane == 0) {
            float gl[4]; int gi = 0;
#pragma unroll
            for (int g = 0; g < 4; ++g) gl[g] = lg[g] + F_BRG[l * NGRP + g];
            float gmax = gl[0];
#pragma unroll
            for (int g = 1; g < 4; ++g) if (gl[g] > gmax) { gmax = gl[g]; gi = g; }
            float den = 0.f;
#pragma unroll
            for (int g = 0; g < 4; ++g) den += __expf(gl[g] - gmax);
            const float gw_ = 1.f / den;
            float el[8];
#pragma unroll
            for (int e = 0; e < 8; ++e) el[e] = 0.f;
#pragma unroll
            for (int g = 0; g < 4; ++g) if (g == gi) {
#pragma unroll
                for (int e = 0; e < 8; ++e) el[e] = lg[4 + 8 * g + e] + F_BRE[l * NEXP + 8 * g + e]; }
            int i0 = 0; float l0 = el[0];
#pragma unroll
            for (int e = 1; e < 8; ++e) if (el[e] > l0) { l0 = el[e]; i0 = e; }
            int i1 = -1; float l1 = -3.0e38f;
#pragma unroll
            for (int e = 0; e < 8; ++e) if (e != i0 && el[e] > l1) { l1 = el[e]; i1 = e; }
            const float ex = __expf(l1 - l0); const float w0 = gw_ / (1.f + ex), w1 = gw_ * ex / (1.f + ex);
            const int e0 = gi * 8 + i0, e1 = gi * 8 + i1;
            const int p0 = (int)atomicAdd(&cnt[e0], 1u), p1 = (int)atomicAdd(&cnt[e1], 1u);
            toke[2 * t] = e0; toke[2 * t + 1] = e1; tokp[2 * t] = p0; tokp[2 * t + 1] = p1;
            tokof[(size_t)e0 * NTOK + p0] = t; tokof[(size_t)e1 * NTOK + p1] = t;
            slotw[(size_t)e0 * NTOK + p0] = w0; slotw[(size_t)e1 * NTOK + p1] = w1;
        }
    }
}

namespace nrm {
typedef _Float16 f16x8 __attribute__((ext_vector_type(8)));
typedef _Float16 f16x4 __attribute__((ext_vector_type(4)));
constexpr int TROW = 2064, L_PART = 32 * TROW, L_LOG = L_PART + 8 * 32 * 48 * 4, L_REC = L_LOG + 32 * 48 * 4, L_LC = L_REC + 8 * 32 * 32, L_GB = L_LC + 128;
static_assert(L_GB + 128 <= LDSCTL_OFF, "norm phase LDS map");
}
template <int MODE>
__device__ __forceinline__ void phase_norm_fast(Frame& F0, int l) {
    using namespace nrm;
    PHASE_FRAME(F0);
    constexpr int NBLK = MODE ? 3 : 1, NC = 16 * NBLK;
    const int lane = F.lane, w = F.wave, tid = F.tid, fr = lane & 15, fq = lane >> 4;
    const float* mod = (const float*)(F.ws + WS_MOD);
    const _Float16* wsm = (const _Float16*)(F.ws + WS_WSM) + ((size_t)l * 64 + (MODE ? 16 : 0)) * DM;
    bf16* H = (bf16*)(F.ws + WS_H);
    LAS unsigned char* lds = F.lds;
    f16x8 bfr[4][NBLK];
#pragma unroll
    for (int ks = 0; ks < 4; ++ks)
#pragma unroll
        for (int nb = 0; nb < NBLK; ++nb) bfr[ks][nb] = *(const f16x8*)(wsm + (size_t)(16 * nb + fr) * DM + 128 * w + 32 * ks + 8 * fq);
    if (MODE == 0 && l > 0) tile_bases(F, l - 1);
    const LAS int* tb = (const LAS int*)(lds + LDSCTL_OFF);
    if (MODE == 1) { if (tid < 32) ((LAS unsigned*)(lds + L_LC))[tid] = 0u; }
    __syncthreads();
    const float* nrmw = (MODE ? F_NFFN : F_NMIX) + l * DM;
    const float* xin = (MODE == 0 && l == 0) ? F_X : F.out;
    int tl = 0;
    for (int tile = F.vcu; tile < NTOK / 32; tile += F.G, ++tl) {
        const int b = (tile * 32) / SEQ;
        const float* mrow = mod + ((size_t)l * NB + b) * NMOD * DM + (MODE ? 3 * DM : 0);
#pragma unroll 1
        for (int rr = 0; rr < 4; ++rr) {
            const int trow = 4 * w + rr; const size_t t = (size_t)tile * 32 + trow;
            f32x4 v[4];
#pragma unroll
            for (int j = 0; j < 4; ++j) v[j] = *(const f32x4*)(xin + t * DM + 4 * lane + 256 * j);
            if (MODE == 0 && l > 0) {
                const int* toke = (const int*)(F.ws + WS_TOKE); const int* tokp = (const int*)(F.ws + WS_TOKP); const bf16* Y = (const bf16*)(F.ws + WS_Y);
                const float* gf = mod + ((size_t)(l - 1) * NB + b) * NMOD * DM + 5 * DM;
                const int e0 = toke[2 * t], e1 = toke[2 * t + 1];
                const size_t s0 = (size_t)tb[e0] * 256 + tokp[2 * t], s1 = (size_t)tb[e1] * 256 + tokp[2 * t + 1];
#pragma unroll
                for (int j = 0; j < 4; ++j) { const int c = 4 * lane + 256 * j;
                    const u32x2 y0 = *(const u32x2*)(Y + s0 * DM + c), y1 = *(const u32x2*)(Y + s1 * DM + c); const f32x4 g = *(const f32x4*)(gf + c);
                    v[j][0] += g[0] * (bflo(y0.x) + bflo(y1.x)); v[j][1] += g[1] * (bfhi(y0.x) + bfhi(y1.x));
                    v[j][2] += g[2] * (bflo(y0.y) + bflo(y1.y)); v[j][3] += g[3] * (bfhi(y0.y) + bfhi(y1.y));
                    *(f32x4*)(F.out + t * DM + c) = v[j]; }
            }
            float ss = 0.f;
#pragma unroll
            for (int j = 0; j < 4; ++j) ss += (v[j][0] * v[j][0] + v[j][1] * v[j][1]) + (v[j][2] * v[j][2] + v[j][3] * v[j][3]);
            const float rstd = 1.f / sqrtf(wave_sum(ss) * (1.f / DM) + EPS);
#pragma unroll
            for (int j = 0; j < 4; ++j) { const int c = 4 * lane + 256 * j;
                const f32x4 gn = *(const f32x4*)(nrmw + c), sh = *(const f32x4*)(mrow + c), sc = *(const f32x4*)(mrow + DM + c);
                f32x4 hv;
#pragma unroll
                for (int i = 0; i < 4; ++i) hv[i] = v[j][i] * rstd * gn[i] * (1.f + sc[i]) + sh[i];
                u32x2 o; o.x = pk2(hv[0], hv[1]); o.y = pk2(hv[2], hv[3]);
                *(u32x2*)(H + t * DM + c) = o;
                *(LAS f16x4*)(lds + trow * TROW + c * 2) = (f16x4){(_Float16)hv[0], (_Float16)hv[1], (_Float16)hv[2], (_Float16)hv[3]}; }
        }
        __syncthreads();
        {
            f32x4 acc[2][NBLK];
#pragma unroll
            for (int mb = 0; mb < 2; ++mb)
#pragma unroll
                for (int nb = 0; nb < NBLK; ++nb) acc[mb][nb] = (f32x4){0.f, 0.f, 0.f, 0.f};
#pragma unroll
            for (int ks = 0; ks < 4; ++ks)
#pragma unroll
                for (int mb = 0; mb < 2; ++mb) { const f16x8 a = *(const LAS f16x8*)(lds + (16 * mb + fr) * TROW + (128 * w + 32 * ks + 8 * fq) * 2);
#pragma unroll
                    for (int nb = 0; nb < NBLK; ++nb) acc[mb][nb] = __builtin_amdgcn_mfma_f32_16x16x32_f16(a, bfr[ks][nb], acc[mb][nb], 0, 0, 0); }
            LAS float* part = (LAS float*)(lds + L_PART) + w * 32 * 48;
#pragma unroll
            for (int mb = 0; mb < 2; ++mb)
#pragma unroll
                for (int nb = 0; nb < NBLK; ++nb)
#pragma unroll
                    for (int i = 0; i < 4; ++i) part[(16 * mb + 4 * fq + i) * 48 + 16 * nb + fr] = acc[mb][nb][i];
        }
        __syncthreads();
        for (int o = tid; o < 32 * NC; o += NTHR) { const int row = o / NC, col = o - row * NC; float a = 0.f;
#pragma unroll
            for (int ww = 0; ww < 8; ++ww) a += ((const LAS float*)(lds + L_PART))[ww * 32 * 48 + row * 48 + col];
            if (MODE == 0) ((float*)(F.ws + WS_GLR))[((size_t)tile * 32 + row) * GRANK + col] = a;
            else ((LAS float*)(lds + L_LOG))[row * 48 + col] = a; }
        if (MODE == 1) {
            __syncthreads();
            if (tid < 32) {
                const LAS float* lg = (const LAS float*)(lds + L_LOG) + tid * 48;
                float gl[4]; int gi = 0;
#pragma unroll
                for (int g = 0; g < 4; ++g) gl[g] = lg[g] + F_BRG[l * NGRP + g];
                float gmax = gl[0];
#pragma unroll
                for (int g = 1; g < 4; ++g) if (gl[g] > gmax) { gmax = gl[g]; gi = g; }
                float den = 0.f;
#pragma unroll
                for (int g = 0; g < 4; ++g) den += __expf(gl[g] - gmax);
                const float gw_ = 1.f / den;
                float el[8];
#pragma unroll
                for (int e = 0; e < 8; ++e) el[e] = lg[4 + 8 * gi + e] + F_BRE[l * NEXP + 8 * gi + e];
                int i0 = 0; float l0 = el[0];
#pragma unroll
                for (int e = 1; e < 8; ++e) if (el[e] > l0) { l0 = el[e]; i0 = e; }
                int i1 = -1; float l1 = -3.0e38f;
#pragma unroll
                for (int e = 0; e < 8; ++e) if (e != i0 && el[e] > l1) { l1 = el[e]; i1 = e; }
                const float ex = __expf(l1 - l0); const float w0 = gw_ / (1.f + ex), w1 = gw_ * ex / (1.f + ex);
                const int e0 = gi * 8 + i0, e1 = gi * 8 + i1;
                LAS unsigned* lc = (LAS unsigned*)(lds + L_LC);
                const unsigned r0 = __hip_atomic_fetch_add(&lc[e0], 1u, __ATOMIC_RELAXED, __HIP_MEMORY_SCOPE_WORKGROUP), r1 = __hip_atomic_fetch_add(&lc[e1], 1u, __ATOMIC_RELAXED, __HIP_MEMORY_SCOPE_WORKGROUP);
                LAS unsigned* rec = (LAS unsigned*)(lds + L_REC) + (tl * 32 + tid) * 8;
                rec[0] = (unsigned)e0; rec[1] = (unsigned)e1; rec[2] = r0; rec[3] = r1; rec[4] = __builtin_bit_cast(unsigned, w0); rec[5] = __builtin_bit_cast(unsigned, w1);
            }
        }
    }
    if (MODE == 1) {
        __syncthreads();
        unsigned* cnt = F.ctl + CW_CNT + l * 64;
        if (tid < 32) { const unsigned c = ((LAS unsigned*)(lds + L_LC))[tid]; ((LAS unsigned*)(lds + L_GB))[tid] = c ? atomicAdd(&cnt[tid], c) : 0u; }
        __syncthreads();
        int* toke = (int*)(F.ws + WS_TOKE); int* tokp = (int*)(F.ws + WS_TOKP); int* tokof = (int*)(F.ws + WS_TOKOF); float* slotw = (float*)(F.ws + WS_SLOTW);
        for (int i = tid; i < tl * 32; i += NTHR) {
            const LAS unsigned* rec = (const LAS unsigned*)(lds + L_REC) + i * 8; const LAS unsigned* gb = (const LAS unsigned*)(lds + L_GB);
            const int tile = F.vcu + (i >> 5) * F.G; const int t = tile * 32 + (i & 31);
            const int e0 = (int)rec[0], e1 = (int)rec[1]; const int p0 = (int)(gb[e0] + rec[2]), p1 = (int)(gb[e1] + rec[3]);
            toke[2 * t] = e0; toke[2 * t + 1] = e1; tokp[2 * t] = p0; tokp[2 * t + 1] = p1;
            tokof[(size_t)e0 * NTOK + p0] = t; tokof[(size_t)e1 * NTOK + p1] = t;
            slotw[(size_t)e0 * NTOK + p0] = __builtin_bit_cast(float, rec[4]); slotw[(size_t)e1 * NTOK + p1] = __builtin_bit_cast(float, rec[5]);
        }
    }
    __syncthreads();
}

__device__ __forceinline__ void phase_pad_lists(Frame& F0, int l) {
    PHASE_FRAME(F0);
    int* tokof = (int*)(F.ws + WS_TOKOF); float* slotw = (float*)(F.ws + WS_SLOTW);
    for (int e = F.vcu; e < NEXP; e += F.G) { const int c = (int)F.ctl[CW_CNT + l * 64 + e]; const int cp = (c + 255) & ~255;
        for (int i = c + F.tid; i < cp; i += NTHR) { tokof[(size_t)e * NTOK + i] = 0; slotw[(size_t)e * NTOK + i] = 0.f; } }
}

__device__ __forceinline__ void phase_logdecay(Frame& F0, int l) {
    PHASE_FRAME(F0);
    const float* GLR = (const float*)(F.ws + WS_GLR); float* LG = (float*)(F.ws + WS_LG);
    for (int idx = F.vcu * NTHR + F.tid; idx < NTOK * GKW; idx += F.G * NTHR) {
        const int t = idx >> 8, c = idx & 255;
        float p = F_BGK[l * GKW + c];
#pragma unroll
        for (int r = 0; r < GRANK; ++r) p += GLR[(size_t)t * GRANK + r] * F_WGK2[((size_t)l * GRANK + r) * GKW + c];
        const float sp = fmaxf(-p, 0.f) + log1pf(__expf(-fabsf(p)));
        LG[idx] = -sp * (1.f / 16.f);
    }
}
__device__ __forceinline__ void phase_sb_naive(Frame& F0) {
    PHASE_FRAME(F0);
    const bf16* P = (const bf16*)(F.ws + WS_PROJ); bf16* MIX = (bf16*)(F.ws + WS_MIX);
    for (int idx = F.vcu * NTHR + F.tid; idx < NB * SBH * SEQ; idx += F.G * NTHR) {
        const int q = idx & (SEQ - 1), h = (idx >> 12) & 7, b = idx >> 15;
        const size_t trow = (size_t)b * SEQ + q;
        float qv[64], o[64];
#pragma unroll
        for (int c = 0; c < 8; ++c) { const u32x4 w = *(const u32x4*)(P + trow * PROJW + PC_Q + h * 64 + 8 * c);
            qv[8 * c] = bflo(w.x); qv[8 * c + 1] = bfhi(w.x); qv[8 * c + 2] = bflo(w.y); qv[8 * c + 3] = bfhi(w.y); qv[8 * c + 4] = bflo(w.z); qv[8 * c + 5] = bfhi(w.z); qv[8 * c + 6] = bflo(w.w); qv[8 * c + 7] = bfhi(w.w); }
#pragma unroll
        for (int d = 0; d < 64; ++d) o[d] = 0.f;
        float accl = 0.f;
        for (int s = q - 1; s >= 0; --s) {
            const bf16* kr = P + ((size_t)b * SEQ + s) * PROJW + PC_K + h * 64;
            float z = 0.f;
#pragma unroll
            for (int c = 0; c < 8; ++c) { const u32x4 w = *(const u32x4*)(kr + 8 * c);
                z += qv[8 * c] * bflo(w.x) + qv[8 * c + 1] * bfhi(w.x) + qv[8 * c + 2] * bflo(w.y) + qv[8 * c + 3] * bfhi(w.y) + qv[8 * c + 4] * bflo(w.z) + qv[8 * c + 5] * bfhi(w.z) + qv[8 * c + 6] * bflo(w.w) + qv[8 * c + 7] * bfhi(w.w); }
            const float lf = -(fmaxf(z, 0.f) + __log2f(1.f + exp2f(-fabsf(z))));
            const float w_ = exp2f(z + lf + accl);
            const bf16* vr = P + ((size_t)b * SEQ + s) * PROJW + PC_V + h * 64;
#pragma unroll
            for (int c = 0; c < 8; ++c) { const u32x4 w = *(const u32x4*)(vr + 8 * c);
                o[8 * c] += w_ * bflo(w.x); o[8 * c + 1] += w_ * bfhi(w.x); o[8 * c + 2] += w_ * bflo(w.y); o[8 * c + 3] += w_ * bfhi(w.y); o[8 * c + 4] += w_ * bflo(w.z); o[8 * c + 5] += w_ * bfhi(w.z); o[8 * c + 6] += w_ * bflo(w.w); o[8 * c + 7] += w_ * bfhi(w.w); }
            accl += lf;
            if (accl < -150.f) break;
        }
#pragma unroll
        for (int c = 0; c < 8; ++c) { u32x4 w; w.x = pk2(o[8 * c], o[8 * c + 1]); w.y = pk2(o[8 * c + 2], o[8 * c + 3]); w.z = pk2(o[8 * c + 4], o[8 * c + 5]); w.w = pk2(o[8 * c + 6], o[8 * c + 7]);
            *(u32x4*)(MIX + trow * DM + h * 64 + 8 * c) = w; }
    }
}

namespace sbk {
typedef _Float16 f16x8 __attribute__((ext_vector_type(8)));
typedef float f32x16 __attribute__((ext_vector_type(16)));
typedef short v4i16_t __attribute__((ext_vector_type(4)));
constexpr int LK = 0, LV = 16384, LF = 32768;
__device__ __forceinline__ unsigned pkh(float a, float b) { return __builtin_bit_cast(unsigned, __builtin_amdgcn_cvt_pkrtz(a, b)); }
__device__ __forceinline__ unsigned pkb(float a, float b) { unsigned r; asm volatile("v_cvt_pk_bf16_f32 %0, %1, %2" : "=v"(r) : "v"(a), "v"(b)); return r; }
__device__ __forceinline__ bf16x8 vfrag(const LAS unsigned char* p) {
    const v4i16_t a = __builtin_amdgcn_ds_read_tr16_b64_v4i16((LAS v4i16_t*)(p)), b = __builtin_amdgcn_ds_read_tr16_b64_v4i16((LAS v4i16_t*)(p + 512));
    return (bf16x8){a[0], a[1], a[2], a[3], b[0], b[1], b[2], b[3]};
}
template <bool DIAG>
__device__ __forceinline__ void tile(const LAS unsigned char* kb, const LAS unsigned char* vb, const bf16x8 (&qf)[4], const f16x8 (&tf)[2], const int (&kofs)[4], const int (&vofs)[2], int qr2, f32x16& accB, f32x16 (&o)[2]) {
    f32x16 s0 = {}, s1 = {};
#pragma unroll
    for (int s = 0; s < 4; ++s) { const bf16x8 k0 = *(const LAS bf16x8*)(kb + kofs[s]), k1 = *(const LAS bf16x8*)(kb + 4096 + kofs[s]);
        s0 = __builtin_amdgcn_mfma_f32_32x32x16_bf16(k0, qf[s], s0, 0, 0, 0); s1 = __builtin_amdgcn_mfma_f32_32x32x16_bf16(k1, qf[s], s1, 0, 0, 0); }
    float l0[16], l1[16];
#pragma unroll
    for (int g = 0; g < 16; ++g) {
        const float z0 = fminf(s0[g], 126.f), z1 = fminf(s1[g], 126.f); s0[g] = z0; s1[g] = z1;
        float a0 = -__builtin_amdgcn_logf(1.f + __builtin_amdgcn_exp2f(z0)), a1 = -__builtin_amdgcn_logf(1.f + __builtin_amdgcn_exp2f(z1));
        if (DIAG) { const int ko = 16 * (g >> 3) + (g & 7); if (!(ko < qr2)) a0 = 0.f; if (!(32 + ko < qr2)) a1 = 0.f; }
        l0[g] = a0; l1[g] = a1;
    }
    f16x8 x0[2], x1[2];
#pragma unroll
    for (int t = 0; t < 2; ++t) { u32x4 a, b;
        a.x = pkh(l0[8 * t], l0[8 * t + 1]); a.y = pkh(l0[8 * t + 2], l0[8 * t + 3]); a.z = pkh(l0[8 * t + 4], l0[8 * t + 5]); a.w = pkh(l0[8 * t + 6], l0[8 * t + 7]);
        b.x = pkh(l1[8 * t], l1[8 * t + 1]); b.y = pkh(l1[8 * t + 2], l1[8 * t + 3]); b.z = pkh(l1[8 * t + 4], l1[8 * t + 5]); b.w = pkh(l1[8 * t + 6], l1[8 * t + 7]);
        x0[t] = __builtin_bit_cast(f16x8, a); x1[t] = __builtin_bit_cast(f16x8, b); }
    const f16x8 ones = {(_Float16)1.f, (_Float16)1.f, (_Float16)1.f, (_Float16)1.f, (_Float16)1.f, (_Float16)1.f, (_Float16)1.f, (_Float16)1.f};
    f32x16 y1 = s1 + accB;
    y1 = __builtin_amdgcn_mfma_f32_32x32x16_f16(tf[0], x1[0], y1, 0, 0, 0); y1 = __builtin_amdgcn_mfma_f32_32x32x16_f16(tf[1], x1[1], y1, 0, 0, 0);
    f32x16 u1 = __builtin_amdgcn_mfma_f32_32x32x16_f16(ones, x1[0], accB, 0, 0, 0); u1 = __builtin_amdgcn_mfma_f32_32x32x16_f16(ones, x1[1], u1, 0, 0, 0);
    f32x16 y0 = s0 + u1;
    y0 = __builtin_amdgcn_mfma_f32_32x32x16_f16(tf[0], x0[0], y0, 0, 0, 0); y0 = __builtin_amdgcn_mfma_f32_32x32x16_f16(tf[1], x0[1], y0, 0, 0, 0);
    accB = __builtin_amdgcn_mfma_f32_32x32x16_f16(ones, x0[0], u1, 0, 0, 0); accB = __builtin_amdgcn_mfma_f32_32x32x16_f16(ones, x0[1], accB, 0, 0, 0);
#pragma unroll
    for (int g = 0; g < 16; ++g) {
        float w0 = __builtin_amdgcn_exp2f(y0[g]), w1 = __builtin_amdgcn_exp2f(y1[g]);
        if (DIAG) { const int ko = 16 * (g >> 3) + (g & 7); if (!(ko < qr2)) w0 = 0.f; if (!(32 + ko < qr2)) w1 = 0.f; }
        y0[g] = w0; y1[g] = w1;
    }
    bf16x8 wf0[2], wf1[2];
#pragma unroll
    for (int t = 0; t < 2; ++t) { u32x4 a, b;
        a.x = pkb(y0[8 * t], y0[8 * t + 1]); a.y = pkb(y0[8 * t + 2], y0[8 * t + 3]); a.z = pkb(y0[8 * t + 4], y0[8 * t + 5]); a.w = pkb(y0[8 * t + 6], y0[8 * t + 7]);
        b.x = pkb(y1[8 * t], y1[8 * t + 1]); b.y = pkb(y1[8 * t + 2], y1[8 * t + 3]); b.z = pkb(y1[8 * t + 4], y1[8 * t + 5]); b.w = pkb(y1[8 * t + 6], y1[8 * t + 7]);
        wf0[t] = __builtin_bit_cast(bf16x8, a); wf1[t] = __builtin_bit_cast(bf16x8, b); }
#pragma unroll
    for (int c = 0; c < 2; ++c) {
#pragma unroll
        for (int t = 0; t < 2; ++t) {
            o[c] = __builtin_amdgcn_mfma_f32_32x32x16_bf16(vfrag(vb + vofs[c] + 2048 * t), wf0[t], o[c], 0, 0, 0);
            o[c] = __builtin_amdgcn_mfma_f32_32x32x16_bf16(vfrag(vb + vofs[c] + 4096 + 2048 * t), wf1[t], o[c], 0, 0, 0); }
    }
}
}
__device__ __forceinline__ void phase_sb_fast(Frame& F0) {
    PHASE_FRAME(F0);
    using namespace sbk;
    unsigned char* ws = F.ws; asm volatile("" : "+s"(ws));
    const bf16* P = (const bf16*)(ws + WS_PROJ); bf16* MIX = (bf16*)(ws + WS_MIX);
    const int tid = F.tid, lane = F.lane, w = F.wave, r = lane & 31, h = lane >> 5;
    LAS unsigned char* lds = F.lds;
    const int pr = (r & ~12) | ((r & 4) << 1) | ((r & 8) >> 1), sw = (pr >> 1) & 7;
    int kofs[4], vofs[2];
#pragma unroll
    for (int s = 0; s < 4; ++s) kofs[s] = pr * 128 + (((2 * s + h) ^ sw) << 4);
    { const int q4 = (lane & 15) >> 2, p4 = lane & 3, gd = (lane >> 4) & 1;
#pragma unroll
      for (int c = 0; c < 2; ++c) { int ch = 4 * c + 2 * gd + (p4 >> 1); ch ^= ((q4 >> 1) << 2); vofs[c] = (8 * h + q4) * 128 + (p4 & 1) * 8 + ch * 16; } }
    f16x8 tf[2];
#pragma unroll
    for (int t = 0; t < 2; ++t) { u32x4 a; unsigned wv[4];
#pragma unroll
        for (int j = 0; j < 4; ++j) { const int k0 = 16 * t + 8 * h + 2 * j; wv[j] = (k0 >= pr ? 0x3C00u : 0u) | (k0 + 1 >= pr ? 0x3C000000u : 0u); }
        a.x = wv[0]; a.y = wv[1]; a.z = wv[2]; a.w = wv[3]; tf[t] = __builtin_bit_cast(f16x8, a); }
    const int srow = tid >> 3, sch = tid & 7;
    const int skofs = LK + srow * 128 + ((sch ^ ((srow >> 1) & 7)) << 4), svofs = LV + srow * 128 + ((sch ^ (((srow >> 1) & 1) << 2)) << 4);
    LAS unsigned* fl = (LAS unsigned*)(lds + LF);
    for (int u = F.vcu; u < NB * SBH * 16; u += F.G) {
        const int qb = u & 15, hd = (u >> 4) & 7, b = u >> 7;
        const size_t tokbase = (size_t)b * SEQ; const int q0 = qb * 256, qs = q0 + 32 * w, dtw = qs >> 6, jt_hi = (q0 + 255) >> 6;
        bf16x8 qf[4];
#pragma unroll
        for (int s = 0; s < 4; ++s) qf[s] = *(const bf16x8*)(P + (tokbase + qs + r) * PROJW + PC_Q + hd * 64 + 16 * s + 8 * h);
        const bf16* kg = P + (tokbase + srow) * PROJW + PC_K + hd * 64 + sch * 8; const bf16* vg = P + (tokbase + srow) * PROJW + PC_V + hd * 64 + sch * 8;
        f32x16 o[2]; o[0] = f32x16{}; o[1] = f32x16{}; f32x16 accB = {};
        bool done = false;
        { const u32x4 kr = *(const u32x4*)(kg + (size_t)jt_hi * 64 * PROJW), vr = *(const u32x4*)(vg + (size_t)jt_hi * 64 * PROJW);
          *(LAS u32x4*)(lds + skofs) = kr; *(LAS u32x4*)(lds + svofs) = vr; }
        __syncthreads();
        int it = 0;
#pragma unroll 1
        for (int jt = jt_hi; jt >= 0; --jt, ++it) {
            if (it > 0) { unsigned nd = 0;
#pragma unroll
                for (int j = 0; j < 8; ++j) nd += fl[((it - 1) & 1) * 8 + j];
                if (__builtin_amdgcn_readfirstlane(nd) == 8u) break; }
            const int cur = (it & 1) * 8192, nxb = ((it + 1) & 1) * 8192;
            u32x4 kr = {}, vr = {};
            if (jt > 0) { kr = *(const u32x4*)(kg + (size_t)(jt - 1) * 64 * PROJW); vr = *(const u32x4*)(vg + (size_t)(jt - 1) * 64 * PROJW); }
            if (!done && jt <= dtw) {
                const int qr2 = qs + r - 64 * jt - 8 * h;
                if (jt == dtw) tile<true>(lds + LK + cur, lds + LV + cur, qf, tf, kofs, vofs, qr2, accB, o);
                else tile<false>(lds + LK + cur, lds + LV + cur, qf, tf, kofs, vofs, qr2, accB, o);
                done = __all(accB[0] < -150.f);
            }
            if (lane == 0) fl[(it & 1) * 8 + w] = done ? 1u : 0u;
            if (jt > 0) { *(LAS u32x4*)(lds + nxb + skofs) = kr; *(LAS u32x4*)(lds + nxb + svofs) = vr; }
            __syncthreads();
        }
        bf16* orow = MIX + (tokbase + qs + r) * DM + hd * 64 + 4 * h;
#pragma unroll
        for (int c = 0; c < 2; ++c)
#pragma unroll
            for (int gg = 0; gg < 4; ++gg) { u32x2 v; v.x = pkb(o[c][4 * gg], o[c][4 * gg + 1]); v.y = pkb(o[c][4 * gg + 2], o[c][4 * gg + 3]); *(u32x2*)(orow + 32 * c + 8 * gg) = v; }
        __syncthreads();
    }
}

__device__ __forceinline__ void phase_gla_naive(Frame& F0) {
    PHASE_FRAME(F0);
    const bf16* P = (const bf16*)(F.ws + WS_PROJ); const float* LG = (const float*)(F.ws + WS_LG); float* OB = (float*)(F.ws + WS_OB);
    for (int idx = F.vcu * NTHR + F.tid; idx < NB * GH * GDV; idx += F.G * NTHR) {
        const int vv = idx & 127, g = (idx >> 7) & 3, b = idx >> 9;
        float S[64];
#pragma unroll
        for (int d = 0; d < 64; ++d) S[d] = 0.f;
        for (int t = 0; t < SEQ; ++t) {
            const size_t trow = (size_t)b * SEQ + t;
            const float vt = bf2f(P[trow * PROJW + PC_GV + g * GDV + vv]);
            float o = 0.f;
#pragma unroll
            for (int c = 0; c < 8; ++c) { const u32x4 kw = *(const u32x4*)(P + trow * PROJW + PC_GK + g * 64 + 8 * c), qw = *(const u32x4*)(P + trow * PROJW + PC_GQ + g * 64 + 8 * c);
                const f32x4 l0 = *(const f32x4*)(LG + trow * GKW + g * 64 + 8 * c), l1 = *(const f32x4*)(LG + trow * GKW + g * 64 + 8 * c + 4);
                S[8 * c]     = __expf(l0[0]) * S[8 * c]     + bflo(kw.x) * vt; o += bflo(qw.x) * S[8 * c];
                S[8 * c + 1] = __expf(l0[1]) * S[8 * c + 1] + bfhi(kw.x) * vt; o += bfhi(qw.x) * S[8 * c + 1];
                S[8 * c + 2] = __expf(l0[2]) * S[8 * c + 2] + bflo(kw.y) * vt; o += bflo(qw.y) * S[8 * c + 2];
                S[8 * c + 3] = __expf(l0[3]) * S[8 * c + 3] + bfhi(kw.y) * vt; o += bfhi(qw.y) * S[8 * c + 3];
                S[8 * c + 4] = __expf(l1[0]) * S[8 * c + 4] + bflo(kw.z) * vt; o += bflo(qw.z) * S[8 * c + 4];
                S[8 * c + 5] = __expf(l1[1]) * S[8 * c + 5] + bfhi(kw.z) * vt; o += bfhi(qw.z) * S[8 * c + 5];
                S[8 * c + 6] = __expf(l1[2]) * S[8 * c + 6] + bflo(kw.w) * vt; o += bflo(qw.w) * S[8 * c + 6];
                S[8 * c + 7] = __expf(l1[3]) * S[8 * c + 7] + bfhi(kw.w) * vt; o += bfhi(qw.w) * S[8 * c + 7];
                asm volatile("" ::: "memory"); }
            OB[trow * GVW + g * GDV + vv] = o;
        }
    }
}
__device__ __forceinline__ void phase_gla_out(Frame& F0, int l) {
    PHASE_FRAME(F0);
    const bf16* P = (const bf16*)(F.ws + WS_PROJ); const float* OB = (const float*)(F.ws + WS_OB); bf16* MIX = (bf16*)(F.ws + WS_MIX);
    const int gw = F.vcu * NWAVES + F.wave, NGW = F.G * NWAVES, lane = F.lane;
    for (int it = gw; it < NTOK * GH; it += NGW) {
        const int t = it >> 2, g = it & 3;
        const f32x2 o = *(const f32x2*)(OB + (size_t)t * GVW + g * GDV + 2 * lane);
        const float rstd = 1.f / sqrtf(wave_sum(o[0] * o[0] + o[1] * o[1]) * (1.f / GDV) + EPS);
        const unsigned gr = *(const unsigned*)(P + (size_t)t * PROJW + PC_GR + g * GDV + 2 * lane);
        const f32x2 gn = *(const f32x2*)(F_GLAGAIN + l * GDV + 2 * lane);
        *(unsigned*)(MIX + (size_t)t * DM + SBW + g * GDV + 2 * lane) = pk2(o[0] * rstd * gn[0] * bflo(gr), o[1] * rstd * gn[1] * bfhi(gr));
    }
}


namespace glak {
using sbk::f16x8; using sbk::f32x16; using sbk::pkb; using sbk::v4i16_t;
__device__ __forceinline__ float bfu_lo(unsigned w) { return __builtin_bit_cast(float, w << 16); }
__device__ __forceinline__ float bfu_hi(unsigned w) { return __builtin_bit_cast(float, w & 0xffff0000u); }
__device__ __forceinline__ bf16x8 scale8(u32x4 q, const float (&e)[8]) {
    u32x4 o; o.x = pkb(bfu_lo(q.x) * e[0], bfu_hi(q.x) * e[1]); o.y = pkb(bfu_lo(q.y) * e[2], bfu_hi(q.y) * e[3]); o.z = pkb(bfu_lo(q.z) * e[4], bfu_hi(q.z) * e[5]); o.w = pkb(bfu_lo(q.w) * e[6], bfu_hi(q.w) * e[7]);
    return __builtin_bit_cast(bf16x8, o);
}
__device__ __forceinline__ void prep(const float* GLR, const float* wg, const float* bg, size_t tok0, int r, int h, int pr, f32x16 (&b)[2][2]) {
    f16x8 af[2], bf[2];
#pragma unroll
    for (int tb = 0; tb < 2; ++tb) { const f32x4 a0 = *(const f32x4*)(GLR + (tok0 + 32 * tb + pr) * GRANK + 8 * h), a1 = *(const f32x4*)(GLR + (tok0 + 32 * tb + pr) * GRANK + 8 * h + 4);
        af[tb] = (f16x8){(_Float16)a0[0], (_Float16)a0[1], (_Float16)a0[2], (_Float16)a0[3], (_Float16)a1[0], (_Float16)a1[1], (_Float16)a1[2], (_Float16)a1[3]}; }
    float bias[2];
#pragma unroll
    for (int db = 0; db < 2; ++db) { float wv[8];
#pragma unroll
        for (int e = 0; e < 8; ++e) wv[e] = wg[(size_t)(8 * h + e) * GKW + 32 * db + r];
        bf[db] = (f16x8){(_Float16)wv[0], (_Float16)wv[1], (_Float16)wv[2], (_Float16)wv[3], (_Float16)wv[4], (_Float16)wv[5], (_Float16)wv[6], (_Float16)wv[7]};
        bias[db] = bg[32 * db + r]; }
    f16x8 lt[2];
#pragma unroll
    for (int t = 0; t < 2; ++t) { u32x4 a; unsigned wv[4];
#pragma unroll
        for (int j = 0; j < 4; ++j) { const int k0 = 16 * t + 8 * h + 2 * j; wv[j] = (k0 <= pr ? 0x3C00u : 0u) | (k0 + 1 <= pr ? 0x3C000000u : 0u); }
        a.x = wv[0]; a.y = wv[1]; a.z = wv[2]; a.w = wv[3]; lt[t] = __builtin_bit_cast(f16x8, a); }
    const f16x8 ones = {(_Float16)1.f, (_Float16)1.f, (_Float16)1.f, (_Float16)1.f, (_Float16)1.f, (_Float16)1.f, (_Float16)1.f, (_Float16)1.f};
#pragma unroll
    for (int db = 0; db < 2; ++db) {
        f16x8 x[2][2];
#pragma unroll
        for (int tb = 0; tb < 2; ++tb) {
            f32x16 p = {}; p = __builtin_amdgcn_mfma_f32_32x32x16_f16(af[tb], bf[db], p, 0, 0, 0);
            float ls[16];
#pragma unroll
            for (int g = 0; g < 16; ++g) { const float v = p[g] + bias[db];
                ls[g] = -(fmaxf(-v, 0.f) + 0.6931471805599453f * __builtin_amdgcn_logf(1.f + __builtin_amdgcn_exp2f(-fabsf(v) * LOG2E))); }
#pragma unroll
            for (int t = 0; t < 2; ++t) x[tb][t] = (f16x8){(_Float16)ls[8 * t], (_Float16)ls[8 * t + 1], (_Float16)ls[8 * t + 2], (_Float16)ls[8 * t + 3], (_Float16)ls[8 * t + 4], (_Float16)ls[8 * t + 5], (_Float16)ls[8 * t + 6], (_Float16)ls[8 * t + 7]};
        }
        f32x16 c0 = {}, c1 = {};
        c0 = __builtin_amdgcn_mfma_f32_32x32x16_f16(lt[0], x[0][0], c0, 0, 0, 0); c0 = __builtin_amdgcn_mfma_f32_32x32x16_f16(lt[1], x[0][1], c0, 0, 0, 0);
        c1 = __builtin_amdgcn_mfma_f32_32x32x16_f16(ones, x[0][0], c1, 0, 0, 0); c1 = __builtin_amdgcn_mfma_f32_32x32x16_f16(ones, x[0][1], c1, 0, 0, 0);
        c1 = __builtin_amdgcn_mfma_f32_32x32x16_f16(lt[0], x[1][0], c1, 0, 0, 0); c1 = __builtin_amdgcn_mfma_f32_32x32x16_f16(lt[1], x[1][1], c1, 0, 0, 0);
        b[0][db] = c0 * (1.f / 16.f); b[1][db] = c1 * (1.f / 16.f);
    }
}
}

__device__ __forceinline__ void phase_gla_g1(Frame& F0, int l) {
    PHASE_FRAME(F0);
    using namespace glak;
    unsigned char* ws = F.ws; asm volatile("" : "+s"(ws));
    const bf16* P = (const bf16*)(ws + WS_PROJ); const bf16* GVT = (const bf16*)(ws + WS_GVT); const float* GLR = (const float*)(ws + WS_GLR);
    float* ST = (float*)(ws + WS_ST); float* DEC = (float*)(ws + WS_DECAY);
    const int lane = F.lane, r = lane & 31, h = lane >> 5, pr = (r & ~12) | ((r & 4) << 1) | ((r & 8) >> 1);
    LAS unsigned char* wl = F.lds + F.wave * GLA_WL;
    int vofs[2];
    { const int q4 = (lane & 15) >> 2, p4 = lane & 3, gd = (lane >> 4) & 1;
#pragma unroll
      for (int c = 0; c < 2; ++c) { int ch = 4 * c + 2 * gd + (p4 >> 1); ch ^= ((q4 >> 1) << 2); vofs[c] = (8 * h + q4) * 128 + (p4 & 1) * 8 + ch * 16; } }
    const float* wgk2 = F_WGK2 + (size_t)l * GRANK * GKW; const float* bgk = F_BGK + l * GKW;
    for (int cid = F.vcu * NWAVES + F.wave; cid < NB * GH * 64; cid += F.G * NWAVES) {
        const int n = cid & 63, g = (cid >> 6) & 3, b = cid >> 8; const size_t tok0 = (size_t)b * SEQ + 64 * n;
#pragma unroll
        for (int j = 0; j < 8; ++j) { const int idx = j * 64 + lane, row = idx >> 3, ch = idx & 7;
            const u32x4 kv = *(const u32x4*)(P + (tok0 + row) * PROJW + PC_GK + g * 64 + ch * 8);
            *(LAS u32x4*)(wl + row * 128 + ((ch ^ (((row >> 1) & 1) << 2)) << 4)) = kv; }
        f32x16 bb[2][2];
        prep(GLR, wgk2 + g * 64, bgk + g * 64, tok0, r, h, pr, bb);
        asm volatile("s_waitcnt lgkmcnt(0)" ::: "memory");
        { float* gb = (float*)(ws + WS_GB) + (size_t)cid * 4096 + (8 * h) * 64 + r;
#pragma unroll
          for (int tb = 0; tb < 2; ++tb)
#pragma unroll
              for (int db = 0; db < 2; ++db)
#pragma unroll
                  for (int gq = 0; gq < 16; ++gq) gb[(32 * tb + 16 * (gq >> 3) + (gq & 7)) * 64 + 32 * db] = bb[tb][db][gq]; }
#pragma unroll
        for (int db = 0; db < 2; ++db) {
            const float bl = __shfl(bb[1][db][15], r + 32);
            if (h == 0) DEC[(size_t)cid * 64 + 32 * db + r] = __expf(bl);
            f32x16 acc[4]; acc[0] = f32x16{}; acc[1] = f32x16{}; acc[2] = f32x16{}; acc[3] = f32x16{};
#pragma unroll
            for (int tb = 0; tb < 2; ++tb)
#pragma unroll
                for (int s2 = 0; s2 < 2; ++s2) {
                    const LAS unsigned char* kp = wl + vofs[db] + 4096 * tb + 2048 * s2;
                    const v4i16_t ka = __builtin_amdgcn_ds_read_tr16_b64_v4i16((LAS v4i16_t*)(kp)), kb = __builtin_amdgcn_ds_read_tr16_b64_v4i16((LAS v4i16_t*)(kp + 512));
                    float e[8];
#pragma unroll
                    for (int j = 0; j < 8; ++j) e[j] = __expf(bl - bb[tb][db][8 * s2 + j]);
                    u32x4 kq; kq.x = (unsigned)(unsigned short)ka[0] | ((unsigned)(unsigned short)ka[1] << 16); kq.y = (unsigned)(unsigned short)ka[2] | ((unsigned)(unsigned short)ka[3] << 16);
                    kq.z = (unsigned)(unsigned short)kb[0] | ((unsigned)(unsigned short)kb[1] << 16); kq.w = (unsigned)(unsigned short)kb[2] | ((unsigned)(unsigned short)kb[3] << 16);
                    const bf16x8 kd = scale8(kq, e);
#pragma unroll
                    for (int vb = 0; vb < 4; ++vb) { const bf16x8 vt = *(const bf16x8*)(GVT + (size_t)(g * GDV + 32 * vb + r) * NTOK + tok0 + 32 * tb + 16 * s2 + 8 * h);
                        acc[vb] = __builtin_amdgcn_mfma_f32_32x32x16_bf16(vt, kd, acc[vb], 0, 0, 0); }
                }
#pragma unroll
            for (int vb = 0; vb < 4; ++vb)
#pragma unroll
                for (int gq = 0; gq < 16; ++gq) ST[((size_t)cid * GDV + 32 * vb + (gq & 3) + 8 * (gq >> 2) + 4 * h) * GDK + 32 * db + r] = acc[vb][gq];
        }
        asm volatile("s_waitcnt lgkmcnt(0)" ::: "memory");
    }
    __syncthreads();
}
__device__ __forceinline__ void phase_gla_g2(Frame& F0) {
    PHASE_FRAME(F0);
    unsigned char* ws = F.ws;
    const float* ST = (const float*)(ws + WS_ST); const float* DEC = (const float*)(ws + WS_DECAY); bf16* STB = (bf16*)(ws + WS_STB);
    for (int idx = F.vcu * NTHR + F.tid; idx < NB * GH * GDV * 32; idx += F.G * NTHR) {
        const int d2 = idx & 31, v = (idx >> 5) & 127, bg = idx >> 12;
        f32x2 carry = {0.f, 0.f};
        const size_t off = (((size_t)bg * 64) * GDV + v) * GDK + 2 * d2; const float* dp = DEC + (size_t)bg * 64 * 64 + 2 * d2;
#pragma unroll 8
        for (int n = 0; n < 64; ++n) { const f32x2 kv = *(const f32x2*)(ST + off + (size_t)n * GDV * GDK), dc = *(const f32x2*)(dp + n * 64);
            *(unsigned*)(STB + off + (size_t)n * GDV * GDK) = pk2(carry[0], carry[1]); carry = dc * carry + kv; }
    }
}
__device__ __forceinline__ void phase_gla_g3(Frame& F0, int l) {
    PHASE_FRAME(F0);
    using namespace glak;
    unsigned char* ws = F.ws;
    const bf16* P = (const bf16*)(ws + WS_PROJ); const bf16* GVT = (const bf16*)(ws + WS_GVT);
    const float* GB = (const float*)(ws + WS_GB); const bf16* STB = (const bf16*)(ws + WS_STB); bf16* MIX = (bf16*)(ws + WS_MIX);
    const int lane = F.lane, r = lane & 31, h = lane >> 5, pr = (r & ~12) | ((r & 4) << 1) | ((r & 8) >> 1);
    const float* gain = F_GLAGAIN + l * GDV;
    for (int cid = F.vcu * NWAVES + F.wave; cid < NB * GH * 64; cid += F.G * NWAVES) {
        const int n = cid & 63, g = (cid >> 6) & 3, b = cid >> 8; const size_t tok0 = (size_t)b * SEQ + 64 * n;
        bf16x8 sf[4][4];
#pragma unroll
        for (int vb = 0; vb < 4; ++vb)
#pragma unroll
            for (int kd = 0; kd < 4; ++kd) sf[vb][kd] = *(const bf16x8*)(STB + ((size_t)cid * GDV + 32 * vb + r) * GDK + 16 * kd + 8 * h);
        const float* gbq = GB + (size_t)cid * 4096 + 8 * h;
#pragma unroll 1
        for (int tb = 0; tb < 2; ++tb) {
            bf16x8 qd[4];
            { const int t = 32 * tb + r;
#pragma unroll
              for (int kd = 0; kd < 4; ++kd) {
                  const f32x4 b0 = *(const f32x4*)(gbq + t * 64 + 16 * kd), b1 = *(const f32x4*)(gbq + t * 64 + 16 * kd + 4);
                  float e[8] = {__expf(b0[0]), __expf(b0[1]), __expf(b0[2]), __expf(b0[3]), __expf(b1[0]), __expf(b1[1]), __expf(b1[2]), __expf(b1[3])};
                  const u32x4 q = *(const u32x4*)(P + (tok0 + t) * PROJW + PC_GQ + g * 64 + 16 * kd + 8 * h);
                  qd[kd] = scale8(q, e); } }
            f32x16 o[4]; o[0] = f32x16{}; o[1] = f32x16{}; o[2] = f32x16{}; o[3] = f32x16{};
#pragma unroll 1
            for (int sb = 0; sb <= tb; ++sb) {
                f32x16 pt = {};
                { const int srow = 32 * sb + pr;
#pragma unroll
                  for (int kd = 0; kd < 4; ++kd) {
                      const f32x4 b0 = *(const f32x4*)(gbq + srow * 64 + 16 * kd), b1 = *(const f32x4*)(gbq + srow * 64 + 16 * kd + 4);
                      float e[8] = {__expf(-b0[0]), __expf(-b0[1]), __expf(-b0[2]), __expf(-b0[3]), __expf(-b1[0]), __expf(-b1[1]), __expf(-b1[2]), __expf(-b1[3])};
                      const u32x4 k = *(const u32x4*)(P + (tok0 + srow) * PROJW + PC_GK + g * 64 + 16 * kd + 8 * h);
                      pt = __builtin_amdgcn_mfma_f32_32x32x16_bf16(scale8(k, e), qd[kd], pt, 0, 0, 0); } }
                if (sb == tb) {
#pragma unroll
                    for (int gq = 0; gq < 16; ++gq) if (16 * (gq >> 3) + 8 * h + (gq & 7) > r) pt[gq] = 0.f; }
#pragma unroll
                for (int s2 = 0; s2 < 2; ++s2) { u32x4 a; a.x = pkb(pt[8 * s2], pt[8 * s2 + 1]); a.y = pkb(pt[8 * s2 + 2], pt[8 * s2 + 3]); a.z = pkb(pt[8 * s2 + 4], pt[8 * s2 + 5]); a.w = pkb(pt[8 * s2 + 6], pt[8 * s2 + 7]);
                    const bf16x8 pf = __builtin_bit_cast(bf16x8, a);
#pragma unroll
                    for (int vb = 0; vb < 4; ++vb) { const bf16x8 vt = *(const bf16x8*)(GVT + (size_t)(g * GDV + 32 * vb + r) * NTOK + tok0 + 32 * sb + 16 * s2 + 8 * h);
                        o[vb] = __builtin_amdgcn_mfma_f32_32x32x16_bf16(vt, pf, o[vb], 0, 0, 0); } }
            }
#pragma unroll
            for (int vb = 0; vb < 4; ++vb)
#pragma unroll
                for (int kd = 0; kd < 4; ++kd) o[vb] = __builtin_amdgcn_mfma_f32_32x32x16_bf16(sf[vb][kd], qd[kd], o[vb], 0, 0, 0);
            float ss = 0.f;
#pragma unroll
            for (int vb = 0; vb < 4; ++vb)
#pragma unroll
                for (int gq = 0; gq < 16; ++gq) ss += o[vb][gq] * o[vb][gq];
            ss += __shfl_xor(ss, 32);
            const float rstd = __builtin_amdgcn_rsqf(ss * (1.f / GDV) + EPS);
            const size_t trow = tok0 + 32 * tb + r;
#pragma unroll
            for (int vb = 0; vb < 4; ++vb)
#pragma unroll
                for (int gg = 0; gg < 4; ++gg) { const int v = 32 * vb + 8 * gg + 4 * h;
                    const f32x4 gn = *(const f32x4*)(gain + v); const u32x2 gr = *(const u32x2*)(P + trow * PROJW + PC_GR + g * GDV + v);
                    u32x2 ov; ov.x = pkb(o[vb][4 * gg] * rstd * gn[0] * bfu_lo(gr.x), o[vb][4 * gg + 1] * rstd * gn[1] * bfu_hi(gr.x));
                    ov.y = pkb(o[vb][4 * gg + 2] * rstd * gn[2] * bfu_lo(gr.y), o[vb][4 * gg + 3] * rstd * gn[3] * bfu_hi(gr.y));
                    *(u32x2*)(MIX + trow * DM + SBW + g * GDV + v) = ov; }
        }
    }
}

constexpr int PH_PER_LAYER = 10, PH_TOTAL = 2 + NL * PH_PER_LAYER;
struct Args { const float* in[20]; float* out; unsigned char* ws; int ph_lo, ph_hi, use_bar, pad; };
template <unsigned MASK>
__global__ void __launch_bounds__(NTHR, 2) fwd_kernel(Args args) {
    extern __shared__ __attribute__((aligned(16))) unsigned char lds[];
    Frame F;
    F.lds = (LAS unsigned char*)lds;
    F.MISC = (volatile LAS unsigned*)(F.lds + MISC_OFF);
    F.tid = threadIdx.x; F.lane = F.tid & 63; F.wave = __builtin_amdgcn_readfirstlane(F.tid >> 6);
    F.G = gridDim.x; { const int bx = blockIdx.x; F.vcu = (F.G % 8 == 0) ? (bx % 8) * (F.G / 8) + bx / 8 : bx; }
    F.out = args.out; F.ws = args.ws; F.ctl = (unsigned*)(args.ws + WS_CTL);
    for (int u = F.tid; u < (LDS_BYTES - LDSCTL_OFF) / 4; u += NTHR) ((LAS unsigned*)(F.lds + LDSCTL_OFF))[u] = 0u;
    __syncthreads();
    if (F.tid < 20) { const unsigned long long pv = (unsigned long long)args.in[F.tid]; LAS unsigned* p = (LAS unsigned*)(F.lds + PTAB_OFF) + 2 * F.tid; p[0] = (unsigned)pv; p[1] = (unsigned)(pv >> 32); }
    __syncthreads();
    XcdBarrier bar; bar.bar = F.ctl + CW_BAR; bar.x = 0; bar.st = nullptr;
    if (args.use_bar) bar = xcd_barrier_post(F.ctl + CW_BAR, F.MISC + 8);
    const int lo = args.ph_lo, hi = args.ph_hi;
#define INB(k, bit) ((((MASK) >> (bit)) & 1u) && lo <= (k) && (k) < hi)
#ifndef PROBE_BIT
#define PROBE_BIT -1
#define PROBE_REP 1
#endif
#ifndef PROBE_L
#define PROBE_L -1
#endif
#define REPS(bit) (((bit) == PROBE_BIT && (PROBE_L < 0 || l == PROBE_L)) ? PROBE_REP : 1)
#define SEAM(k) do { if (MASK == 0xFFFu && lo <= (k) && (k) + 1 < hi) xcd_barrier(bar); } while (0)
    { const int l = 0; if (INB(0, 10)) { for (int rep_ = 0; rep_ < REPS(10); ++rep_) { p0_prologue(F); SEAM(0); } } }
    for (int l = 0; l < NL; ++l) {
        const int pb = 1 + l * PH_PER_LAYER;
        const float* mod = (const float*)(F.ws + WS_MOD) + (size_t)l * NB * NMOD * DM;
        if (INB(pb + 0, 0)) { for (int rep_ = 0; rep_ < REPS(0); ++rep_) {
#ifdef NORM_NAIVE
            phase_norm_a(F, l);
#else
            phase_norm_fast<0>(F, l);
#endif
            SEAM(pb + 0); } }
        if (INB(pb + 1, 1)) { for (int rep_ = 0; rep_ < REPS(1); ++rep_) {
            pg8::Gemm g{(const bf16*)(F.ws + WS_H), (const bf16*)(F.ws + WS_WIN) + (size_t)l * PROJW * DM, DM, nullptr};
#ifdef GLA_NAIVE
            pg8::StaticOrder S; S.init(NTOK, PROJW, F.G, (int)blockIdx.x);
            pg8::EpiProj E{(bf16*)(F.ws + WS_PROJ), F_QGAIN + l * SBD, F_KGAIN + l * SBD};
            pg8::gemm_phase<pg8::EpiProj, pg8::StaticOrder, false, true, true>(F.lds, g, S, E);
#else
            pg8::StaticOrder S; S.init(NTOK, PROJW - 512, F.G, (int)blockIdx.x); S.skip_from = 8; S.skip_n = 2;
            pg8::EpiProj E{(bf16*)(F.ws + WS_PROJ), F_QGAIN + l * SBD, F_KGAIN + l * SBD};
            pg8::gemm_phase<pg8::EpiProj, pg8::StaticOrder, false, true, true>(F.lds, g, S, E);
            pg8::Gemm g2{(const bf16*)(F.ws + WS_WIN) + ((size_t)l * PROJW + PC_GV) * DM, (const bf16*)(F.ws + WS_H), DM, nullptr};
            pg8::StaticOrder S2; S2.init(GVW, NTOK, F.G, (int)blockIdx.x);
            pg8::EpiStore E2{(bf16*)(F.ws + WS_GVT), NTOK};
            pg8::gemm_phase<pg8::EpiStore, pg8::StaticOrder, false, true, true>(F.lds, g2, S2, E2);
#endif
            SEAM(pb + 1);
        } }
        if (INB(pb + 2, 2)) { for (int rep_ = 0; rep_ < REPS(2); ++rep_) {
#ifdef GLA_NAIVE
            phase_logdecay(F, l);
#else
            for (int r2_ = 0; r2_ < REPS(12); ++r2_) phase_gla_g1(F, l);
#endif
#ifdef SB_NAIVE
            phase_sb_naive(F);
#else
            for (int r2_ = 0; r2_ < REPS(13); ++r2_) phase_sb_fast(F);
#endif
            SEAM(pb + 2); } }
#ifdef GLA_NAIVE
        if (INB(pb + 3, 3)) { for (int rep_ = 0; rep_ < REPS(3); ++rep_) { phase_gla_naive(F); SEAM(pb + 3); } }
        if (INB(pb + 4, 4)) { for (int rep_ = 0; rep_ < REPS(4); ++rep_) { phase_gla_out(F, l); SEAM(pb + 4); } }
#else
        if (INB(pb + 3, 3)) { for (int rep_ = 0; rep_ < REPS(3); ++rep_) { phase_gla_g2(F); SEAM(pb + 3); } }
        if (INB(pb + 4, 4)) { for (int rep_ = 0; rep_ < REPS(4); ++rep_) { phase_gla_g3(F, l); SEAM(pb + 4); } }
#endif
        if (INB(pb + 5, 5)) { for (int rep_ = 0; rep_ < REPS(5); ++rep_) {
            pg8::Gemm g{(const bf16*)(F.ws + WS_MIX), (const bf16*)(F.ws + WS_WOUT) + (size_t)l * DM * DM, DM, nullptr};
            pg8::StaticOrder S; S.init(NTOK, DM, F.G, (int)blockIdx.x);
            pg8::EpiResid E{l == 0 ? F_X : F.out, F.out, mod + 2 * DM};
            pg8::gemm_phase<pg8::EpiResid, pg8::StaticOrder, false, true, true>(F.lds, g, S, E);
            SEAM(pb + 5);
        } }
        if (INB(pb + 6, 6)) { for (int rep_ = 0; rep_ < REPS(6); ++rep_) {
#ifdef NORM_NAIVE
            phase_norm_e(F, l);
#else
            phase_norm_fast<1>(F, l);
#endif
            SEAM(pb + 6); } }
        if (INB(pb + 7, 7)) { for (int rep_ = 0; rep_ < REPS(7); ++rep_) { } }
        if (INB(pb + 8, 8)) { for (int rep_ = 0; rep_ < REPS(8); ++rep_) {
            tile_bases(F, l);
            pg8::Gemm g{(const bf16*)(F.ws + WS_H), (const bf16*)(F.ws + WS_W1) + (size_t)l * NEXP * 512 * DM, DM, (const int*)(F.ws + WS_TOKOF)};
            pg8::GroupedOrder S{(const LAS int*)(F.lds + LDSCTL_OFF), 2, F.G, (int)blockIdx.x};
            pg8::EpiMoeAct E{(bf16*)(F.ws + WS_ACT), (const float*)(F.ws + WS_SLOTW)};
            pg8::gemm_phase<pg8::EpiMoeAct, pg8::GroupedOrder, true, true, true>(F.lds, g, S, E);
            SEAM(pb + 8);
        } }
        if (INB(pb + 9, 9)) { for (int rep_ = 0; rep_ < REPS(9); ++rep_) {
            tile_bases(F, l);
            pg8::Gemm g{(const bf16*)(F.ws + WS_ACT), (const bf16*)(F.ws + WS_W2) + (size_t)l * NEXP * DM * DEXP, DEXP, nullptr};
            pg8::GroupedOrder S{(const LAS int*)(F.lds + LDSCTL_OFF), 4, F.G, (int)blockIdx.x};
            pg8::EpiStore E{(bf16*)(F.ws + WS_Y), DM};
            pg8::gemm_phase<pg8::EpiStore, pg8::GroupedOrder, false, true, true>(F.lds, g, S, E);
            SEAM(pb + 9);
        } }
    }
    if (INB(PH_TOTAL - 1, 11)) phase_norm_a(F, NL);
#undef INB
#undef SEAM
}

#ifndef N_LAUNCH_MODE
#define N_LAUNCH_MODE 1
#endif
static const void* kfun(int j) {
    switch (j) {
        case 0: return (const void*)fwd_kernel<1u << 0>; case 1: return (const void*)fwd_kernel<1u << 1>; case 2: return (const void*)fwd_kernel<1u << 2>; case 3: return (const void*)fwd_kernel<1u << 3>;
        case 4: return (const void*)fwd_kernel<1u << 4>; case 5: return (const void*)fwd_kernel<1u << 5>; case 6: return (const void*)fwd_kernel<1u << 6>; case 7: return (const void*)fwd_kernel<1u << 7>;
        case 8: return (const void*)fwd_kernel<1u << 8>; case 9: return (const void*)fwd_kernel<1u << 9>; case 10: return (const void*)fwd_kernel<1u << 10>; case 11: return (const void*)fwd_kernel<1u << 11>;
#if N_LAUNCH_MODE == 1
        default: return (const void*)fwd_kernel<0xFFFu>;
#else
        default: return (const void*)fwd_kernel<1u << 11>;
#endif
    }
}
extern "C" void kernel_launch(void* const* d_in, const int* in_sizes, int n_in, void* d_out, int out_size, void* d_ws, size_t ws_size, hipStream_t stream) {
    static int grid = 0;
    if (grid == 0) {
        if (n_in != 20 || out_size != NTOK * DM || ws_size < WS_END) { fprintf(stderr, "kernel_launch: unexpected sizes (n_in %d, out %d, ws %zu)\n", n_in, out_size, ws_size); grid = -1; return; }
        int dev = 0, cus = 0;
        if (hipGetDevice(&dev) != hipSuccess || hipDeviceGetAttribute(&cus, hipDeviceAttributeMultiprocessorCount, dev) != hipSuccess) { grid = -1; return; }
        for (int j = 0; j < 13; ++j) if (hipFuncSetAttribute(kfun(j), hipFuncAttributeMaxDynamicSharedMemorySize, LDS_BYTES) != hipSuccess) { fprintf(stderr, "kernel_launch: hipFuncSetAttribute failed\n"); grid = -1; return; }
        (void)hipGetLastError();
        grid = cus;
    }
    if (grid < 0) return;
    (void)hipMemsetAsync((char*)d_ws + WS_CTL, 0, CTL_ZERO_BYTES, stream);
    Args a{};
    for (int i = 0; i < 20; ++i) a.in[i] = (const float*)d_in[i];
    a.out = (float*)d_out; a.ws = (unsigned char*)d_ws; a.pad = 0;
    if (N_LAUNCH_MODE == 1) {
        a.ph_lo = 0; a.ph_hi = PH_TOTAL; a.use_bar = 1;
        void* av[] = {&a};
        (void)hipLaunchKernel(kfun(12), dim3(grid), dim3(NTHR), av, LDS_BYTES, stream);
    } else {
        for (int p = 0; p < PH_TOTAL; ++p) { a.ph_lo = p; a.ph_hi = p + 1; a.use_bar = 0;
            const int j = (p == 0) ? 10 : (p == PH_TOTAL - 1 ? 11 : (p - 1) % PH_PER_LAYER);
            void* av[] = {&a};
            (void)hipLaunchKernel(kfun(j), dim3(grid), dim3(NTHR), av, LDS_BYTES, stream); }
    }
}
```
